# Optimizing an MI355X kernel written in HIP

```python
import math
import jax
import jax.numpy as jnp
from jax import lax
import numpy as np

D_MODEL = 1024
BATCH = 16
SEQ = 256
DEPTH = 4
DEC_BATCH = 8
DEC_SEQ = 2048
PAST_LEN = 256

GRID_W = 64
N_MIXERS = 4
N_LAYERS_MLA = len(range(0, DEPTH, N_MIXERS))
N_LAYERS_DIFF = len(range(1, DEPTH, N_MIXERS))
N_LAYERS_SCONV = len(range(2, DEPTH, N_MIXERS))
N_LAYERS_GMLP = len(range(3, DEPTH, N_MIXERS))
EPS = 1e-6
ROPE_THETA = 10000.0
Q_BLOCK = 128
MLA_HEADS = 8
MLA_NOPE = 128
MLA_ROPE = 64
MLA_V = 128
MLA_Q_LORA = 768
MLA_KV_LORA = 256
DIFF_HEADS = 8
DIFF_HD = D_MODEL // (2 * DIFF_HEADS)
GMLP_WIDTH = D_MODEL
GMLP_CHUNK = 128
GMLP_GROUPS = 8
FFN_HIDDEN = 2816
N_MOD = 6

kernel_name = "hybrid_diffusion_prefix_step"


def _rms(x, g):
    xf = x.astype(jnp.float32)
    y = xf * lax.rsqrt(jnp.mean(xf * xf, axis=-1, keepdims=True) + EPS)
    return (y * g.astype(jnp.float32)).astype(x.dtype)


def _modulate(x, g, shift, scale):
    return _rms(x, g) * (1 + scale) + shift


def _axial_rope_tables(s, rope_dim):
    rows = s // GRID_W
    row = jnp.repeat(jnp.arange(rows, dtype=jnp.float32), GRID_W)
    col = jnp.tile(jnp.arange(GRID_W, dtype=jnp.float32), rows)
    n_freq = rope_dim // 4
    inv_freq = ROPE_THETA ** (-jnp.arange(n_freq, dtype=jnp.float32) / n_freq)
    ang = jnp.concatenate([row[:, None] * inv_freq, col[:, None] * inv_freq], axis=-1)
    return jnp.cos(ang), jnp.sin(ang)


def _rope(x, cos, sin):
    s, half = cos.shape
    bshape = (1, s) + (1,) * (x.ndim - 3) + (half,)
    cos = cos.reshape(bshape)
    sin = sin.reshape(bshape)
    xf = x.astype(jnp.float32)
    x1, x2 = xf[..., :half], xf[..., half:]
    return jnp.concatenate([x1 * cos - x2 * sin, x2 * cos + x1 * sin], axis=-1).astype(x.dtype)


def _dwconv3(x, w):
    xp = jnp.pad(x, ((0, 0), (1, 1), (0, 0)))
    return xp[:, :-2] * w[0] + xp[:, 1:-1] * w[1] + xp[:, 2:] * w[2]


def _attend(q, k, v):
    b, sq, g, h, d = q.shape
    nb = sq // Q_BLOCK
    scale = d ** -0.5
    qb = jnp.moveaxis(q.reshape(b, nb, Q_BLOCK, g, h, d), 1, 0)

    def block(qi):
        s = jnp.einsum('bqghd,bkghd->bghqk', qi, k).astype(jnp.float32) * scale
        p = jax.nn.softmax(s, axis=-1).astype(v.dtype)
        return jnp.einsum('bghqk,bkhe->bqghe', p, v)

    o = lax.map(block, qb)
    return jnp.moveaxis(o, 0, 1).reshape(b, sq, g, h, v.shape[-1])


def _mla(h, rope, ctx, w_down, q_norm, kv_norm, w_uq, w_uk, w_uv, qn_nope, qn_rope, kn_nope, kn_rope, w_o):
    b, s, _ = h.shape
    c_q, c_kv, k_rope = jnp.split(h @ w_down, [MLA_Q_LORA, MLA_Q_LORA + MLA_KV_LORA], axis=-1)
    q = (_rms(c_q, q_norm) @ w_uq).reshape(b, s, MLA_HEADS, MLA_NOPE + MLA_ROPE)
    q_nope = _rms(q[..., :MLA_NOPE], qn_nope)
    q_rope = _rms(q[..., MLA_NOPE:], qn_rope)
    c_kv = _rms(c_kv, kv_norm)
    k_rope = _rms(k_rope, kn_rope)
    if rope is None:
        ckv_all, kr_all = c_kv, k_rope
    else:
        q_rope = _rope(q_rope, *rope)
        ckv_all = jnp.concatenate([ctx[0], c_kv], axis=1)
        kr_all = jnp.concatenate([ctx[1], _rope(k_rope, *rope)], axis=1)
    l = ckv_all.shape[1]
    k_nope = _rms((ckv_all @ w_uk).reshape(b, l, MLA_HEADS, MLA_NOPE), kn_nope)
    k_pe = jnp.broadcast_to(kr_all[:, :, None, :], (b, l, MLA_HEADS, MLA_ROPE))
    k = jnp.concatenate([k_nope, k_pe], axis=-1)[:, :, None]
    v = (ckv_all @ w_uv).reshape(b, l, MLA_HEADS, MLA_V)
    qf = jnp.concatenate([q_nope, q_rope], axis=-1)[:, :, None]
    o = _attend(qf, k, v).reshape(b, s, MLA_HEADS * MLA_V)
    return o @ w_o, c_kv, k_rope


def _diff(h, rope, ctx, lam_init, w_qkv, qn, kn, lq1, lk1, lq2, lk2, head_norm, w_o):
    b, s, _ = h.shape
    q, k, v = jnp.split(h @ w_qkv, 3, axis=-1)
    q = _rms(q.reshape(b, s, 2, DIFF_HEADS, DIFF_HD), qn)
    k = _rms(k.reshape(b, s, 2, DIFF_HEADS, DIFF_HD), kn)
    v = v.reshape(b, s, DIFF_HEADS, 2 * DIFF_HD)
    if rope is None:
        k_all, v_all = k, v
    else:
        q = _rope(q, *rope)
        k_all = jnp.concatenate([ctx[0], _rope(k, *rope)], axis=1)
        v_all = jnp.concatenate([ctx[1], v], axis=1)
    o = _attend(q, k_all, v_all)
    lam = (jnp.exp(jnp.sum(lq1.astype(jnp.float32) * lk1.astype(jnp.float32)))
           - jnp.exp(jnp.sum(lq2.astype(jnp.float32) * lk2.astype(jnp.float32))) + lam_init).astype(o.dtype)
    o = o[:, :, 0] - lam * o[:, :, 1]
    o = _rms(o, head_norm) * (1.0 - lam_init)
    return o.reshape(b, s, D_MODEL) @ w_o, k, v


def _short_conv(h, w_in, conv_w, w_out):
    gb, gc, u = jnp.split(h @ w_in, 3, axis=-1)
    return (gb * _dwconv3(gc * u, conv_w)) @ w_out


def _chunk_gmlp(h, w_in, v_norm, w_s, b_s, w_out):
    b, s, _ = h.shape
    u, v = jnp.split(jax.nn.gelu(h @ w_in), 2, axis=-1)
    v = _rms(v, v_norm).reshape(b, s // GMLP_CHUNK, GMLP_CHUNK, GMLP_GROUPS, GMLP_WIDTH // GMLP_GROUPS)
    mixed = jnp.einsum('gpq,bcqge->bcpge', w_s, v) + b_s.T[None, None, :, :, None]
    return (u * mixed.reshape(b, s, GMLP_WIDTH)) @ w_out


def _conv_ffn(h, w_in, conv_w, conv_b, w_out):
    a = _dwconv3(h @ w_in, conv_w) + conv_b
    g, up = jnp.split(a, 2, axis=-1)
    return (jax.nn.silu(g) * up) @ w_out


def setup_inputs(seed: int = 0) -> dict:
    key = jax.random.key(seed)
    ks = iter(jax.random.split(key, 64))

    def nrm(shape, scale=1.0):
        return jax.random.normal(next(ks), shape, jnp.float32) * scale

    def gain(shape):
        return 1.0 + nrm(shape, 0.02)

    D = D_MODEL
    nA, nB, nC, nD = N_LAYERS_MLA, N_LAYERS_DIFF, N_LAYERS_SCONV, N_LAYERS_GMLP
    return {
        "x_prompt": nrm((BATCH, SEQ, D)),
        "x_sample": nrm((DEC_BATCH, DEC_SEQ, D)),
        "cache_mla_ckv": nrm((DEC_BATCH, nA, PAST_LEN, MLA_KV_LORA)),
        "cache_mla_krope": nrm((DEC_BATCH, nA, PAST_LEN, MLA_ROPE)),
        "cache_diff_k": nrm((DEC_BATCH, nB, PAST_LEN, 2, DIFF_HEADS, DIFF_HD)),
        "cache_diff_v": nrm((DEC_BATCH, nB, PAST_LEN, DIFF_HEADS, 2 * DIFF_HD)),
        "c": nrm((DEC_BATCH, D)),
        "c_ctx": nrm((D,)),
        "ada_w": nrm((DEPTH, D, N_MOD * D), 0.5 * D ** -0.5),
        "ada_b": nrm((DEPTH, N_MOD * D), 0.02),
        "norm1_g": gain((DEPTH, D)),
        "norm2_g": gain((DEPTH, D)),
        "mla_w_down": nrm((nA, D, MLA_Q_LORA + MLA_KV_LORA + MLA_ROPE), D ** -0.5),
        "mla_q_norm": gain((nA, MLA_Q_LORA)),
        "mla_kv_norm": gain((nA, MLA_KV_LORA)),
        "mla_w_uq": nrm((nA, MLA_Q_LORA, MLA_HEADS * (MLA_NOPE + MLA_ROPE)), MLA_Q_LORA ** -0.5),
        "mla_w_uk": nrm((nA, MLA_KV_LORA, MLA_HEADS * MLA_NOPE), MLA_KV_LORA ** -0.5),
        "mla_w_uv": nrm((nA, MLA_KV_LORA, MLA_HEADS * MLA_V), MLA_KV_LORA ** -0.5),
        "mla_qn_nope": gain((nA, MLA_NOPE)),
        "mla_qn_rope": gain((nA, MLA_ROPE)),
        "mla_kn_nope": gain((nA, MLA_NOPE)),
        "mla_kn_rope": gain((nA, MLA_ROPE)),
        "mla_w_o": nrm((nA, MLA_HEADS * MLA_V, D), (MLA_HEADS * MLA_V) ** -0.5),
        "diff_w_qkv": nrm((nB, D, 3 * D), D ** -0.5),
        "diff_qn": gain((nB, DIFF_HD)),
        "diff_kn": gain((nB, DIFF_HD)),
        "diff_lq1": nrm((nB, DIFF_HD), 0.1),
        "diff_lk1": nrm((nB, DIFF_HD), 0.1),
        "diff_lq2": nrm((nB, DIFF_HD), 0.1),
        "diff_lk2": nrm((nB, DIFF_HD), 0.1),
        "diff_head_norm": gain((nB, 2 * DIFF_HD)),
        "diff_w_o": nrm((nB, D, D), D ** -0.5),
        "sconv_w_in": nrm((nC, D, 3 * D), D ** -0.5),
        "sconv_w": nrm((nC, 3, D), 3 ** -0.5),
        "sconv_w_out": nrm((nC, D, D), D ** -0.5),
        "gmlp_w_in": nrm((nD, D, 2 * GMLP_WIDTH), D ** -0.5),
        "gmlp_v_norm": gain((nD, GMLP_WIDTH)),
        "gmlp_w_s": nrm((nD, GMLP_GROUPS, GMLP_CHUNK, GMLP_CHUNK), GMLP_CHUNK ** -0.5),
        "gmlp_b_s": 1.0 + nrm((nD, GMLP_GROUPS, GMLP_CHUNK), 0.01),
        "gmlp_w_out": nrm((nD, GMLP_WIDTH, D), GMLP_WIDTH ** -0.5),
        "ffn_w_in": nrm((DEPTH, D, 2 * FFN_HIDDEN), D ** -0.5),
        "ffn_conv_w": nrm((DEPTH, 3, 2 * FFN_HIDDEN), 3 ** -0.5),
        "ffn_conv_b": nrm((DEPTH, 2 * FFN_HIDDEN), 0.02),
        "ffn_w_out": nrm((DEPTH, FFN_HIDDEN, D), FFN_HIDDEN ** -0.5),
    }


def reference(x_prompt, x_sample, cache_mla_ckv, cache_mla_krope, cache_diff_k, cache_diff_v, c,
              c_ctx, ada_w, ada_b, norm1_g, norm2_g,
              mla_w_down, mla_q_norm, mla_kv_norm, mla_w_uq, mla_w_uk, mla_w_uv,
              mla_qn_nope, mla_qn_rope, mla_kn_nope, mla_kn_rope, mla_w_o,
              diff_w_qkv, diff_qn, diff_kn, diff_lq1, diff_lk1, diff_lq2, diff_lk2, diff_head_norm, diff_w_o,
              sconv_w_in, sconv_w, sconv_w_out,
              gmlp_w_in, gmlp_v_norm, gmlp_w_s, gmlp_b_s, gmlp_w_out,
              ffn_w_in, ffn_conv_w, ffn_conv_b, ffn_w_out):
    s_lat = x_sample.shape[1]
    rope_mla = _axial_rope_tables(s_lat, MLA_ROPE)
    rope_diff = _axial_rope_tables(s_lat, DIFF_HD)
    cond_ctx = jax.nn.silu(c_ctx)[None, :]
    cond_lat = jax.nn.silu(c)
    yp, ys = x_prompt, x_sample
    st_ckv, st_kr, st_dk, st_dv = [], [], [], []
    for i in range(DEPTH):
        kind, j = i % N_MIXERS, i // N_MIXERS
        mod_p = jnp.split((cond_ctx @ ada_w[i] + ada_b[i])[:, None, :], N_MOD, axis=-1)
        mod_s = jnp.split((cond_lat @ ada_w[i] + ada_b[i])[:, None, :], N_MOD, axis=-1)
        hp = _modulate(yp, norm1_g[i], mod_p[0], mod_p[1])
        hs = _modulate(ys, norm1_g[i], mod_s[0], mod_s[1])
        if kind == 0:
            prm = (mla_w_down[j], mla_q_norm[j], mla_kv_norm[j], mla_w_uq[j], mla_w_uk[j], mla_w_uv[j],
                   mla_qn_nope[j], mla_qn_rope[j], mla_kn_nope[j], mla_kn_rope[j], mla_w_o[j])
            mp, ckv_p, kr_p = _mla(hp, None, None, *prm)
            ms, _, _ = _mla(hs, rope_mla, (cache_mla_ckv[:, j], cache_mla_krope[:, j]), *prm)
            st_ckv.append(ckv_p)
            st_kr.append(kr_p)
        elif kind == 1:
            lam_init = 0.8 - 0.6 * math.exp(-0.3 * i)
            prm = (diff_w_qkv[j], diff_qn[j], diff_kn[j], diff_lq1[j], diff_lk1[j], diff_lq2[j], diff_lk2[j],
                   diff_head_norm[j], diff_w_o[j])
            mp, k_p, v_p = _diff(hp, None, None, lam_init, *prm)
            ms, _, _ = _diff(hs, rope_diff, (cache_diff_k[:, j], cache_diff_v[:, j]), lam_init, *prm)
            st_dk.append(k_p)
            st_dv.append(v_p)
        elif kind == 2:
            prm = (sconv_w_in[j], sconv_w[j], sconv_w_out[j])
            mp = _short_conv(hp, *prm)
            ms = _short_conv(hs, *prm)
        else:
            prm = (gmlp_w_in[j], gmlp_v_norm[j], gmlp_w_s[j], gmlp_b_s[j], gmlp_w_out[j])
            mp = _chunk_gmlp(hp, *prm)
            ms = _chunk_gmlp(hs, *prm)
        yp = yp + mod_p[2] * mp
        ys = ys + mod_s[2] * ms
        fprm = (ffn_w_in[i], ffn_conv_w[i], ffn_conv_b[i], ffn_w_out[i])
        yp = yp + mod_p[5] * _conv_ffn(_modulate(yp, norm2_g[i], mod_p[3], mod_p[4]), *fprm)
        ys = ys + mod_s[5] * _conv_ffn(_modulate(ys, norm2_g[i], mod_s[3], mod_s[4]), *fprm)
    state_mla_ckv = jnp.stack(st_ckv, axis=1)
    state_mla_krope = jnp.stack(st_kr, axis=1)
    state_diff_k = jnp.stack(st_dk, axis=1)
    state_diff_v = jnp.stack(st_dv, axis=1)
    return (yp, ys, state_mla_ckv, state_mla_krope, state_diff_k, state_diff_v)
```

```cpp
#include <hip/hip_runtime.h>
#include <hip/hip_cooperative_groups.h>
#include <cstdio>
namespace cg = cooperative_groups;

#define LAS __attribute__((address_space(3)))
typedef unsigned short bf16_t;
typedef short bf16x8 __attribute__((ext_vector_type(8)));
typedef float f32x4 __attribute__((ext_vector_type(4)));
typedef unsigned u32x4 __attribute__((ext_vector_type(4)));
typedef unsigned u32x2 __attribute__((ext_vector_type(2)));

#ifndef SYNC_MODE
#define SYNC_MODE 1
#endif

constexpr int T = 20480, TP = 4096, D = 1024, KVT = 22528, LLAT = 2304;
constexpr int NTHREADS = 512;
constexpr int LDS_BYTES = 131072 + 64;
constexpr float EPS = 1e-6f;
constexpr float LOG2E = 1.4426950408889634f;

constexpr size_t OW_DOWN = 0, OW_UQ = 1310720, OW_UKV = 2490368, OW_OMLA = 3014656, OW_QKV = 4063232, OW_ODIFF = 7208960,
                 OW_SIN = 8257536, OW_SOUT = 11403264, OW_GIN = 12451840, OW_GS = 14548992, OW_GOUT = 14680064, OW_FFN = 15728640,
                 FFN_STRIDE = 8650752, FIN_ELEMS = 5767168;
constexpr size_t WS_W = 0, WS_MOD = 100663296, WS_ROPE = 101548032, WS_H = 102072320, WS_AR = 148209664, WS_BAR = 372342784, WS_GST = WS_BAR + 16384, WS_END = WS_GST + 81920;
constexpr size_t A_CQ = 0, A_KVIN = 31457280, A_KR = 42991616, A_DN = 45875200, A_QH = 45875200, A_KH = A_QH + 62914560, A_VT = A_KH + 69206016;
constexpr size_t D_QH = 0, D_KH = 41943040, D_VT = 88080384, D_O2 = 134217728;
constexpr size_t F_ACT = 0, F_HALO = 115343360;
constexpr size_t O_CKV = 20971520, O_KR = 22020096, O_DK = 22282240, O_DV = 26476544;

struct Params { const float* in[44]; float* out; unsigned char* ws; };
typedef const __attribute__((address_space(4))) Params* KP;

__device__ __forceinline__ int tidx() { int t = (int)threadIdx.x; asm volatile("" : "+v"(t)); return t; }
__device__ __forceinline__ int bidx() { int b = (int)blockIdx.x; asm volatile("" : "+s"(b)); return b; }
__device__ __forceinline__ unsigned cvt_pk_bf16(float lo, float hi) { unsigned r; asm volatile("v_cvt_pk_bf16_f32 %0, %1, %2" : "=v"(r) : "v"(lo), "v"(hi)); return r; }
__device__ __forceinline__ unsigned cvt_pk_bf16_mf(float lo, float hi) { unsigned r; asm volatile("v_cvt_pk_bf16_f32 %0, %1, %2\n\ts_nop 1" : "=v"(r) : "v"(lo), "v"(hi)); return r; }
__device__ __forceinline__ bf16_t f2bf(float x) { return (bf16_t)(cvt_pk_bf16(x, 0.f) & 0xffffu); }
__device__ __forceinline__ float bf2f(unsigned b) { return __uint_as_float(b << 16); }
__device__ __forceinline__ float bflo(unsigned w) { return __uint_as_float(w << 16); }
__device__ __forceinline__ float bfhi(unsigned w) { return __uint_as_float(w & 0xffff0000u); }
__device__ __forceinline__ float wave_sum(float v) {
#pragma unroll
    for (int o = 32; o >= 1; o >>= 1) v += __shfl_xor(v, o);
    return v;
}
__device__ __forceinline__ float silu_f(float x) { return x * __builtin_amdgcn_rcpf(1.0f + __builtin_amdgcn_exp2f(-x * LOG2E)); }
__device__ __forceinline__ float gelu_tanh_f(float x) {
    const float z = 0.7978845608028654f * (x + 0.044715f * x * x * x);
    const float e = __builtin_amdgcn_exp2f(2.0f * LOG2E * z);
    const float th = 1.0f - 2.0f * __builtin_amdgcn_rcpf(e + 1.0f);
    return 0.5f * x * (1.0f + th);
}
__device__ __forceinline__ const float* xrow(const float* xp, const float* xs, int row) { return row < TP ? xp + (size_t)row * D : xs + (size_t)(row - TP) * D; }
__device__ __forceinline__ int kvrow_of(int row) { if (row < TP) return row; const int r = row - TP; return TP + (r >> 11) * LLAT + 256 + (r & 2047); }

namespace pg8 {
constexpr int BM = 256, BK = 64, HALF = 128, HTB = HALF * BK * 2, NXCD = 8, WGM = 8;
__device__ __forceinline__ int lds_byte(int r, int c) { const int st = (r >> 4) * 2 + (c >> 5), rr = r & 15, cc = c & 31, ob = rr * 64 + cc * 2; return st * 1024 + (ob ^ (((ob >> 9) & 1) << 5)); }
__device__ __forceinline__ void stage_rc(int b, int& R, int& C) { const int st = b / 1024, sb = b % 1024, swz = sb ^ (((sb >> 9) & 1) << 5); R = (st >> 1) * 16 + swz / 64; C = (st & 1) * 32 + (swz % 64) / 2; }
__device__ __forceinline__ int perm32(int rho) { const int n = rho >> 4, i = rho & 15; return 8 * (i >> 2) + 4 * n + (i & 3); }
struct Unit { int pm, pn; };
struct Gemm { const bf16_t* A; const bf16_t* Bt; int M, N, K; };
struct StaticOrder {
    int nM, nN, nwg, G, c;
    __device__ void init(int M, int N, int G_, int c_) { nM = M / BM; nN = N / BM; nwg = nM * nN; G = G_; c = c_; }
    __device__ bool next(int i, Unit& u) const {
        const long L = (long)i * G + c; if (L >= nwg) return false;
        int wgid = (int)L; { const int q = nwg / NXCD, r = nwg % NXCD, xcd = wgid % NXCD, off = wgid / NXCD; wgid = (xcd < r ? xcd * (q + 1) : r * (q + 1) + (xcd - r) * q) + off; }
        const int nig = WGM * nN, gid = wgid / nig, fm = gid * WGM, gsz = (nM - fm) < WGM ? (nM - fm) : WGM;
        u.pm = fm + ((wgid % nig) % gsz); u.pn = (wgid % nig) / gsz; return true;
    }
};

struct PanelOrder {
    int c, round;
    __device__ __forceinline__ bool next(int i, Unit& u) const {
        if (i > 0) return false;
        const int xcd = c & 7, idx = c >> 3;
        if (round == 0) { u.pm = xcd * 8 + (idx >> 2); u.pn = idx & 3; return true; }
        if (c >= 64) return false;
        u.pm = 64 + xcd * 2 + (idx >> 2); u.pn = idx & 3; return true;
    }
};
template <class Epi, class Sched>
__device__ __forceinline__ void gemm_phase(LAS unsigned char* lds, const Gemm g, const Sched& S, const Epi& E) {
    const int tid = tidx(), wid = __builtin_amdgcn_readfirstlane(tid >> 6), lane = tid & 63, wr = wid >> 2, wc = wid & 3, fr = lane & 15, fq = lane >> 4;
    int K = g.K; asm volatile("" : "+s"(K)); const int nt = K / BK;
    unsigned voffA[2], voffB[2];
#pragma unroll
    for (int i = 0; i < 2; ++i) { int R, C; stage_rc(tid * 16 + i * 8192, R, C); const int Rb = Epi::PERM ? ((R & ~31) + perm32(R & 31)) : R;
        const int Ra = Epi::APERM ? (128 * (R >> 6) + 8 * (R & 15) + ((R >> 4) & 3)) : R;
        voffA[i] = (unsigned)(Ra * K + C) * 2u; voffB[i] = (unsigned)(Rb * K + C) * 2u; }
    const size_t kstep = (size_t)(BK * 2);
    const size_t hstepB = (size_t)HALF * K * 2;
    const size_t hstepA = Epi::APERM ? (size_t)4 * K * 2 : hstepB;
    const size_t tstep = 2 * hstepB;
    const unsigned ldsw = (unsigned)wid * 1024u;
    const int aoff = lds_byte(wr * 64 + fr, fq * 8), boff = lds_byte(wc * 32 + fr, fq * 8);
#define PG8_SA(b, h) (((b) * 2 + (h)) * HTB)
#define PG8_SB(b, h) ((4 + (b) * 2 + (h)) * HTB)
#define PG8_STAGE(bufoff, gbase, voff) do { _Pragma("unroll") for (int _i = 0; _i < 2; ++_i) \
        __builtin_amdgcn_global_load_lds((const unsigned*)((const char*)(gbase) + (voff)[_i]), (LAS unsigned*)(lds + (bufoff) + ldsw + _i * 8192), 16, 0, 0); } while (0)
#define PG8_LDA(dst, b, h) do { _Pragma("unroll") for (int m = 0; m < 4; ++m) _Pragma("unroll") for (int k = 0; k < 2; ++k) dst[m][k] = *(const LAS bf16x8*)(lds + PG8_SA(b, h) + aoff + m * 2048 + k * 1024); } while (0)
#define PG8_LDB(dst, b, h) do { _Pragma("unroll") for (int n = 0; n < 2; ++n) _Pragma("unroll") for (int k = 0; k < 2; ++k) dst[n][k] = *(const LAS bf16x8*)(lds + PG8_SB(b, h) + boff + n * 2048 + k * 1024); } while (0)
#define PG8_MMA(ai, bj, At, Bt) do { __builtin_amdgcn_s_setprio(1); _Pragma("unroll") for (int m = 0; m < 4; ++m) _Pragma("unroll") for (int n = 0; n < 2; ++n) _Pragma("unroll") for (int k = 0; k < 2; ++k) \
        acc[ai][bj][m][n] = __builtin_amdgcn_mfma_f32_16x16x32_bf16(Bt[n][k], At[m][k], acc[ai][bj][m][n], 0, 0, 0); __builtin_amdgcn_s_setprio(0); } while (0)
#define PG8_WAIT_V(n) asm volatile("s_waitcnt vmcnt(" #n ")" ::: "memory")
#define PG8_WAIT_L(n) asm volatile("s_waitcnt lgkmcnt(" #n ")" ::: "memory")
#define PG8_BAR __builtin_amdgcn_s_barrier()
#define PG8_SCHED __builtin_amdgcn_sched_barrier(0)
    Unit cur, nxt; int ui = 0;
    if (!S.next(0, cur)) return;
    f32x4 acc[2][2][4][2];
#pragma unroll
    for (int a = 0; a < 2; ++a)
#pragma unroll
        for (int b = 0; b < 2; ++b)
#pragma unroll
            for (int m = 0; m < 4; ++m)
#pragma unroll
                for (int n = 0; n < 2; ++n) acc[a][b][m][n] = (f32x4){0.f, 0.f, 0.f, 0.f};
    bf16x8 At[4][2], B0[2][2], B1[2][2];
    const char* cA = (const char*)g.A + (size_t)cur.pm * tstep; const char* cB = (const char*)g.Bt + (size_t)cur.pn * tstep;
    PG8_STAGE(PG8_SB(0, 0), cB, voffB); PG8_STAGE(PG8_SA(0, 0), cA, voffA); PG8_STAGE(PG8_SB(0, 1), cB + hstepB, voffB); PG8_STAGE(PG8_SA(0, 1), cA + hstepA, voffA);
    if (wr == 1) PG8_BAR;
    PG8_WAIT_V(4); PG8_BAR;
    PG8_STAGE(PG8_SB(1, 0), cB + kstep, voffB); PG8_STAGE(PG8_SA(1, 0), cA + kstep, voffA); PG8_STAGE(PG8_SB(1, 1), cB + hstepB + kstep, voffB);
    PG8_WAIT_V(6); PG8_BAR;
    for (;;) {
        const bool has_next = S.next(ui + 1, nxt);
        const char* nA = has_next ? (const char*)g.A + (size_t)nxt.pm * tstep : cA; const char* nB = has_next ? (const char*)g.Bt + (size_t)nxt.pn * tstep : cB;
        for (int t = 0; t < nt; t += 2) {
            const bool last = (t == nt - 2);
            const char* a1 = cA + (size_t)(t + 1) * kstep;
            const char* a2 = last ? nA : cA + (size_t)(t + 2) * kstep; const char* b2 = last ? nB : cB + (size_t)(t + 2) * kstep;
            const char* a3 = a2 + kstep; const char* b3 = b2 + kstep;
            PG8_LDB(B0, 0, 0); PG8_SCHED; PG8_LDA(At, 0, 0); PG8_STAGE(PG8_SA(1, 1), a1 + hstepA, voffA);
            PG8_WAIT_L(8); PG8_BAR; PG8_WAIT_L(0); PG8_MMA(0, 0, At, B0); PG8_BAR; PG8_SCHED;
            PG8_LDB(B1, 0, 1); PG8_STAGE(PG8_SB(0, 0), b2, voffB);
            PG8_BAR; PG8_WAIT_L(0); PG8_MMA(0, 1, At, B1); PG8_BAR;
            PG8_LDA(At, 0, 1); PG8_STAGE(PG8_SA(0, 0), a2, voffA);
            PG8_BAR; PG8_WAIT_L(0); PG8_MMA(1, 0, At, B0); PG8_BAR; PG8_SCHED;
            PG8_STAGE(PG8_SB(0, 1), b2 + hstepB, voffB);
            PG8_WAIT_V(6); PG8_BAR; PG8_MMA(1, 1, At, B1); PG8_BAR;
            PG8_LDB(B0, 1, 0); PG8_SCHED; PG8_LDA(At, 1, 0); PG8_STAGE(PG8_SA(0, 1), a2 + hstepA, voffA);
            PG8_WAIT_L(8); PG8_BAR; PG8_WAIT_L(0); PG8_MMA(0, 0, At, B0); PG8_BAR; PG8_SCHED;
            PG8_LDB(B1, 1, 1); PG8_STAGE(PG8_SB(1, 0), b3, voffB);
            PG8_BAR; PG8_WAIT_L(0); PG8_MMA(0, 1, At, B1); PG8_BAR;
            PG8_LDA(At, 1, 1); PG8_STAGE(PG8_SA(1, 0), a3, voffA);
            PG8_BAR; PG8_WAIT_L(0); PG8_MMA(1, 0, At, B0); PG8_BAR; PG8_SCHED;
            PG8_STAGE(PG8_SB(1, 1), b3 + hstepB, voffB);
            PG8_WAIT_V(6); PG8_BAR; PG8_MMA(1, 1, At, B1); PG8_BAR;
        }
        E(acc, cur, wr, wc, fr, fq);
        if (!has_next) break;
#pragma unroll
        for (int a = 0; a < 2; ++a)
#pragma unroll
            for (int b = 0; b < 2; ++b)
#pragma unroll
                for (int m = 0; m < 4; ++m)
#pragma unroll
                    for (int n = 0; n < 2; ++n) acc[a][b][m][n] = (f32x4){0.f, 0.f, 0.f, 0.f};
        cur = nxt; cA = nA; cB = nB; ++ui;
    }
    PG8_WAIT_V(0);
    if (wr == 0) PG8_BAR;
    PG8_BAR;
#undef PG8_SA
#undef PG8_SB
#undef PG8_STAGE
#undef PG8_LDA
#undef PG8_LDB
#undef PG8_MMA
#undef PG8_WAIT_V
#undef PG8_WAIT_L
#undef PG8_BAR
#undef PG8_SCHED
}
}
using pg8::Unit;
typedef f32x4 Acc[2][2][4][2];

struct EpiF32Plain {
    static constexpr bool PERM = false, APERM = false;
    float* C; int ldc;
    __device__ __forceinline__ void operator()(Acc& acc, const Unit& u, int wr, int wc, int fr, int fq) const {
        asm volatile("" : "+v"(fr), "+v"(fq));
        const int row0 = u.pm * 256 + wr * 64 + fr, col0 = u.pn * 256 + wc * 32 + 4 * fq;
#pragma unroll
        for (int ai = 0; ai < 2; ++ai)
#pragma unroll
            for (int m = 0; m < 4; ++m) { float* rowp = C + (size_t)(row0 + ai * 128 + m * 16) * ldc + col0;
#pragma unroll
                for (int bj = 0; bj < 2; ++bj)
#pragma unroll
                    for (int n = 0; n < 2; ++n) *(f32x4*)(rowp + bj * 128 + n * 16) = acc[ai][bj][m][n]; }
    }
};
struct EpiResid {
    static constexpr bool PERM = false, APERM = false;
    const float* xp; const float* xs; float* Y; float* Yo; const float* gate; int first;
    __device__ __forceinline__ void operator()(Acc& acc, const Unit& u, int wr, int wc, int fr, int fq) const {
        asm volatile("" : "+v"(fr), "+v"(fq));
        const int cr = u.pm < 16 ? 0 : 1 + ((u.pm - 16) >> 3);
        const float* g = gate + cr * 6144;
        const int row0 = u.pm * 256 + wr * 64 + fr, col0 = u.pn * 256 + wc * 32 + 4 * fq;
        f32x4 gv[2][2];
#pragma unroll
        for (int bj = 0; bj < 2; ++bj)
#pragma unroll
            for (int n = 0; n < 2; ++n) gv[bj][n] = *(const f32x4*)(g + col0 + bj * 128 + n * 16);
#pragma unroll
        for (int ai = 0; ai < 2; ++ai)
#pragma unroll
            for (int m = 0; m < 4; ++m) { const int row = row0 + ai * 128 + m * 16;
                const float* b = first ? xrow(xp, xs, row) : Y + (size_t)row * D; float* o = Yo + (size_t)row * D;
#pragma unroll
                for (int bj = 0; bj < 2; ++bj)
#pragma unroll
                    for (int n = 0; n < 2; ++n) { const int c = col0 + bj * 128 + n * 16; *(f32x4*)(o + c) = *(const f32x4*)(b + c) + gv[bj][n] * acc[ai][bj][m][n]; } }
    }
};
template <int ACT> struct EpiBf16 {
    static constexpr bool PERM = true, APERM = false;
    bf16_t* O; int ldc; float* vst; int vpn0;
    __device__ __forceinline__ void operator()(Acc& acc, const Unit& u, int wr, int wc, int fr, int fq) const {
        asm volatile("" : "+v"(fr), "+v"(fq));
        const int row0 = u.pm * 256 + wr * 64 + fr, col0 = u.pn * 256 + wc * 32 + 8 * fq;
        const bool dost = vst != nullptr && u.pn >= vpn0;
#pragma unroll
        for (int ai = 0; ai < 2; ++ai)
#pragma unroll
            for (int m = 0; m < 4; ++m) { const int row = row0 + ai * 128 + m * 16; bf16_t* rowp = O + (size_t)row * ldc + col0; float ss = 0.f;
#pragma unroll
                for (int bj = 0; bj < 2; ++bj) { f32x4 v0 = acc[ai][bj][m][0], v1 = acc[ai][bj][m][1];
                    if (ACT == 1) {
#pragma unroll
                        for (int j = 0; j < 4; ++j) { v0[j] = gelu_tanh_f(v0[j]); v1[j] = gelu_tanh_f(v1[j]); } }
                    ss += (v0[0] * v0[0] + v0[1] * v0[1]) + (v0[2] * v0[2] + v0[3] * v0[3]) + (v1[0] * v1[0] + v1[1] * v1[1]) + (v1[2] * v1[2] + v1[3] * v1[3]);
                    u32x4 w; w.x = cvt_pk_bf16(v0[0], v0[1]); w.y = cvt_pk_bf16(v0[2], v0[3]); w.z = cvt_pk_bf16(v1[0], v1[1]); w.w = cvt_pk_bf16(v1[2], v1[3]);
                    *(u32x4*)(rowp + bj * 128) = w; }
                if (dost) { ss += __shfl_xor(ss, 16); ss += __shfl_xor(ss, 32); if (fq == 0) (void)__hip_atomic_fetch_add(vst + row, ss, __ATOMIC_RELAXED, __HIP_MEMORY_SCOPE_AGENT); } }
    }
};
struct EpiKV {
    static constexpr bool PERM = true, APERM = false;
    bf16_t* Kh; bf16_t* Vr;
    __device__ __forceinline__ void operator()(Acc& acc, const Unit& u, int wr, int wc, int fr, int fq) const {
        asm volatile("" : "+v"(fr), "+v"(fq));
        const int row0 = u.pm * 256 + wr * 64 + fr;
        bf16_t* dst; int ld, bjs;
        if (u.pn < 4) { dst = Kh + 2 * u.pn * 192 + wc * 32 + 8 * fq; ld = 1536; bjs = 192; }
        else { dst = Vr + (u.pn - 4) * 256 + wc * 32 + 8 * fq; ld = 1024; bjs = 128; }
#pragma unroll
        for (int ai = 0; ai < 2; ++ai)
#pragma unroll
            for (int m = 0; m < 4; ++m) { bf16_t* rowp = dst + (size_t)(row0 + ai * 128 + m * 16) * ld;
#pragma unroll
                for (int bj = 0; bj < 2; ++bj) { const f32x4 v0 = acc[ai][bj][m][0], v1 = acc[ai][bj][m][1];
                    u32x4 w; w.x = cvt_pk_bf16(v0[0], v0[1]); w.y = cvt_pk_bf16(v0[2], v0[3]); w.z = cvt_pk_bf16(v1[0], v1[1]); w.w = cvt_pk_bf16(v1[2], v1[3]);
                    *(u32x4*)(rowp + bj * bjs) = w; } }
    }
};
struct EpiQKV {
    static constexpr bool PERM = true, APERM = false;
    bf16_t* Qh; bf16_t* Kh; bf16_t* Vr; float* sdv;
    __device__ __forceinline__ void operator()(Acc& acc, const Unit& u, int wr, int wc, int fr, int fq) const {
        asm volatile("" : "+v"(fr), "+v"(fq));
        const int rl0 = wr * 64 + fr;
        int kvrow0;
        if (u.pm < 16) kvrow0 = u.pm * 256; else { const int r = u.pm - 16; kvrow0 = TP + (r >> 3) * LLAT + 256 + (r & 7) * 256; }
        const int sec = u.pn >> 2, cb = (u.pn & 3) * 256 + wc * 32 + 8 * fq;
        bf16_t* dst = sec == 0 ? Qh + (size_t)(u.pm * 256) * 1024 : (sec == 1 ? Kh : Vr) + (size_t)kvrow0 * 1024;
        dst += cb;
#pragma unroll
        for (int ai = 0; ai < 2; ++ai)
#pragma unroll
            for (int m = 0; m < 4; ++m) { const int rl = rl0 + ai * 128 + m * 16; bf16_t* rowp = dst + (size_t)rl * 1024;
#pragma unroll
                for (int bj = 0; bj < 2; ++bj) { const f32x4 v0 = acc[ai][bj][m][0], v1 = acc[ai][bj][m][1];
                    u32x4 w; w.x = cvt_pk_bf16(v0[0], v0[1]); w.y = cvt_pk_bf16(v0[2], v0[3]); w.z = cvt_pk_bf16(v1[0], v1[1]); w.w = cvt_pk_bf16(v1[2], v1[3]);
                    *(u32x4*)(rowp + bj * 128) = w;
                    if (sec == 2 && u.pm < 16) { float* sp = sdv + (size_t)(u.pm * 256 + rl) * 1024 + cb + bj * 128; *(f32x4*)sp = v0; *(f32x4*)(sp + 4) = v1; } } }
    }
};
struct EpiFFN {
    static constexpr bool PERM = true, APERM = true;
    bf16_t* ACT; float* HALO; const float* cw; const float* cb;
    __device__ __forceinline__ void operator()(Acc& acc, const Unit& u, int wr, int wc, int fr, int fq) const {
        asm volatile("" : "+v"(fr), "+v"(fq));
        const int tbase = u.pm * 256 + wr * 128 + fr * 8;
        const int run = u.pm * 2 + wr;
#pragma unroll
        for (int n = 0; n < 2; ++n) {
            const int ch = u.pn * 128 + wc * 32 + 8 * fq + 4 * n;
            f32x4 Gm, Gp, Um, Up;
#pragma unroll
            for (int i = 0; i < 4; ++i) { Gm[i] = __shfl_up(acc[1][0][3][n][i], 1); Gp[i] = __shfl_down(acc[0][0][0][n][i], 1);
                                          Um[i] = __shfl_up(acc[1][1][3][n][i], 1); Up[i] = __shfl_down(acc[0][1][0][n][i], 1); }
            if (fr == 0) { float* h = HALO + (size_t)(run * 4) * 5632;
                *(f32x4*)(h + ch) = acc[0][0][0][n]; *(f32x4*)(h + 2816 + ch) = acc[0][1][0][n];
                *(f32x4*)(h + 5632 + ch) = acc[0][0][1][n]; *(f32x4*)(h + 5632 + 2816 + ch) = acc[0][1][1][n]; }
            if (fr == 15) { float* h = HALO + (size_t)(run * 4 + 2) * 5632;
                *(f32x4*)(h + ch) = acc[1][0][2][n]; *(f32x4*)(h + 2816 + ch) = acc[1][1][2][n];
                *(f32x4*)(h + 5632 + ch) = acc[1][0][3][n]; *(f32x4*)(h + 5632 + 2816 + ch) = acc[1][1][3][n]; }
            {
                const f32x4 w0 = *(const f32x4*)(cw + ch), w1 = *(const f32x4*)(cw + 5632 + ch), w2 = *(const f32x4*)(cw + 11264 + ch), bb = *(const f32x4*)(cb + ch);
                f32x4 prev = Gm;
#pragma unroll
                for (int j = 0; j < 8; ++j) { const f32x4 cur = acc[j >> 2][0][j & 3][n]; const f32x4 nx = j == 7 ? Gp : acc[(j + 1) >> 2][0][(j + 1) & 3][n];
                    const f32x4 cg = w0 * prev + w1 * cur + w2 * nx + bb; f32x4 o;
#pragma unroll
                    for (int i = 0; i < 4; ++i) o[i] = silu_f(cg[i]);
                    acc[j >> 2][0][j & 3][n] = o; prev = cur; }
            }
            {
                const f32x4 w0 = *(const f32x4*)(cw + 2816 + ch), w1 = *(const f32x4*)(cw + 5632 + 2816 + ch), w2 = *(const f32x4*)(cw + 11264 + 2816 + ch), bb = *(const f32x4*)(cb + 2816 + ch);
                f32x4 prev = Um;
#pragma unroll
                for (int j = 0; j < 8; ++j) { const f32x4 cur = acc[j >> 2][1][j & 3][n]; const f32x4 nx = j == 7 ? Up : acc[(j + 1) >> 2][1][(j + 1) & 3][n];
                    const f32x4 o = (w0 * prev + w1 * cur + w2 * nx + bb) * acc[j >> 2][0][j & 3][n]; prev = cur;
                    const bool edge = (j == 0 && fr == 0) || (j == 7 && fr == 15);
                    if (!edge) { u32x2 w; w.x = cvt_pk_bf16(o[0], o[1]); w.y = cvt_pk_bf16(o[2], o[3]); *(u32x2*)(ACT + (size_t)(tbase + j) * 2816 + ch) = w; } }
            }
        }
    }
};

__device__ __forceinline__ void conv_job(LAS unsigned char* lds, const float* src, bf16_t* dst, int K, int N, int rowoff, int mode, int& base, int G, int bi) {
    const int tid = tidx();
    const int tn = N / 64, ntiles = (K / 64) * tn;
    LAS float* tile = (LAS float*)lds;
    int start = (bi - (base % G) + G) % G;
    for (int t = start; t < ntiles; t += G) {
        const int k0 = (t / tn) * 64, n0 = (t % tn) * 64;
        __syncthreads();
#pragma unroll
        for (int i = 0; i < 8; ++i) { const int idx = tid + 512 * i, kk = idx >> 6, nn = idx & 63; tile[kk * 65 + nn] = src[(size_t)(k0 + kk) * N + n0 + nn]; }
        __syncthreads();
        const int nn = tid >> 3, kg = tid & 7; float v[8];
#pragma unroll
        for (int j = 0; j < 8; ++j) v[j] = tile[(kg * 8 + j) * 65 + nn];
        const int n = n0 + nn; int dr;
        if (mode == 0) dr = n + rowoff; else { const int isup = n >= 2816, n2 = isup ? n - 2816 : n; dr = 256 * (n2 >> 7) + (isup ? 128 : 0) + (n2 & 127); }
        u32x4 w; w.x = cvt_pk_bf16(v[0], v[1]); w.y = cvt_pk_bf16(v[2], v[3]); w.z = cvt_pk_bf16(v[4], v[5]); w.w = cvt_pk_bf16(v[6], v[7]);
        *(u32x4*)(dst + (size_t)dr * K + k0 + kg * 8) = w;
    }
    base += ntiles;
}

__device__ void conv_next(KP p, LAS unsigned char* lds, int nl, int ffn, int nb, int bi) {
    bf16_t* W = (bf16_t*)(p->ws + WS_W);
    int base = 0;
    __syncthreads();
    if (ffn) {
        conv_job(lds, p->in[40] + (size_t)nl * 1024 * 5632, W + OW_FFN + nl * FFN_STRIDE, 1024, 5632, 0, 1, base, nb, bi);
        conv_job(lds, p->in[43] + (size_t)nl * 2816 * 1024, W + OW_FFN + nl * FFN_STRIDE + FIN_ELEMS, 2816, 1024, 0, 0, base, nb, bi);
    } else if (nl == 1) {
        conv_job(lds, p->in[23], W + OW_QKV, 1024, 3072, 0, 0, base, nb, bi);
        conv_job(lds, p->in[31], W + OW_ODIFF, 1024, 1024, 0, 0, base, nb, bi);
    } else if (nl == 2) {
        conv_job(lds, p->in[32], W + OW_SIN, 1024, 3072, 0, 0, base, nb, bi);
        conv_job(lds, p->in[34], W + OW_SOUT, 1024, 1024, 0, 0, base, nb, bi);
    } else {
        conv_job(lds, p->in[35], W + OW_GIN, 1024, 2048, 0, 0, base, nb, bi);
        conv_job(lds, p->in[39], W + OW_GOUT, 1024, 1024, 0, 0, base, nb, bi);
        for (int i = bi * NTHREADS + tidx(); i < 131072 / 4; i += nb * NTHREADS) { const f32x4 v = *(const f32x4*)(p->in[37] + (size_t)i * 4); u32x2 w; w.x = cvt_pk_bf16(v[0], v[1]); w.y = cvt_pk_bf16(v[2], v[3]); *(u32x2*)(W + OW_GS + (size_t)i * 4) = w; }
    }
}

__device__ void phase0(KP p, LAS unsigned char* lds) {
    bf16_t* W = (bf16_t*)(p->ws + WS_W);
    const int G = gridDim.x, tid = tidx(), gtid = bidx() * NTHREADS + tid, gn = G * NTHREADS;
    int base = 0;
    conv_job(lds, p->in[12], W + OW_DOWN, 1024, 1088, 0, 0, base, G, bidx());
    conv_job(lds, p->in[15], W + OW_UQ, 768, 1536, 0, 0, base, G, bidx());
    conv_job(lds, p->in[16], W + OW_UKV, 256, 1024, 0, 0, base, G, bidx());
    conv_job(lds, p->in[17], W + OW_UKV, 256, 1024, 1024, 0, base, G, bidx());
    conv_job(lds, p->in[22], W + OW_OMLA, 1024, 1024, 0, 0, base, G, bidx());
    conv_job(lds, p->in[40], W + OW_FFN, 1024, 5632, 0, 1, base, G, bidx());
    conv_job(lds, p->in[43], W + OW_FFN + FIN_ELEMS, 2816, 1024, 0, 0, base, G, bidx());
    for (int i = gtid; i < T / 4; i += gn) *(f32x4*)((float*)(p->ws + WS_GST) + 4 * i) = (f32x4){0.f, 0.f, 0.f, 0.f};
    for (int i = gtid; i < 192 * 1024 / 8; i += gn) *(u32x4*)(W + OW_DOWN + (size_t)1088 * 1024 + (size_t)i * 8) = (u32x4){0u, 0u, 0u, 0u};
    { float* RC = (float*)(p->ws + WS_ROPE); float* RS = RC + 65536;
      for (int i = gtid; i < 65536; i += gn) { const int s = i >> 5, f = i & 31, fi = f & 15; const float pos = (float)(f < 16 ? (s >> 6) : (s & 63));
          const float inv = exp2f(-(float)fi * (13.287712379549449f / 16.0f)); const float ang = pos * inv; RC[i] = __cosf(ang); RS[i] = __sinf(ang); } }
    { bf16_t* KVIN = (bf16_t*)(p->ws + WS_AR + A_KVIN); bf16_t* KR = (bf16_t*)(p->ws + WS_AR + A_KR);
      for (int i = gtid; i < 8 * 256 * 256 / 4; i += gn) { const int e = i * 4, c = e & 255, pp = (e >> 8) & 255, b = e >> 16; const f32x4 v = *(const f32x4*)(p->in[2] + e);
          u32x2 w; w.x = cvt_pk_bf16(v[0], v[1]); w.y = cvt_pk_bf16(v[2], v[3]); *(u32x2*)(KVIN + (size_t)(TP + b * LLAT + pp) * 256 + c) = w; }
      for (int i = gtid; i < 8 * 256 * 64 / 4; i += gn) { const int e = i * 4, c = e & 63, pp = (e >> 6) & 255, b = e >> 14; const f32x4 v = *(const f32x4*)(p->in[3] + e);
          u32x2 w; w.x = cvt_pk_bf16(v[0], v[1]); w.y = cvt_pk_bf16(v[2], v[3]); *(u32x2*)(KR + (size_t)(TP + b * LLAT + pp) * 64 + c) = w; } }
    { float* MOD = (float*)(p->ws + WS_MOD); LAS float* sc = (LAS float*)lds;
      const int wid = tid >> 6, lane = tid & 63;
      __syncthreads();
      for (int i = tid; i < 9 * 1024; i += NTHREADS) { const int r = i >> 10, k = i & 1023; const float c = r == 0 ? p->in[7][k] : p->in[6][(r - 1) * 1024 + k]; sc[i] = silu_f(c); }
      __syncthreads();
      LAS float* part = sc + 9 * 1024;
      const int rg = lane >> 4, cg = lane & 15;
      for (int it = bidx(); it < 4 * 96; it += G) {
          const int layer = it / 96, n0 = (it % 96) * 64;
          const float* w = p->in[8] + (size_t)layer * 1024 * 6144 + n0 + cg * 4;
          f32x4 a[9];
#pragma unroll
          for (int r = 0; r < 9; ++r) a[r] = (f32x4){0.f, 0.f, 0.f, 0.f};
          const int kb = wid * 128 + rg;
#pragma unroll 8
          for (int j = 0; j < 32; ++j) { const int k = kb + 4 * j; const f32x4 wv = *(const f32x4*)(w + (size_t)k * 6144);
#pragma unroll
              for (int r = 0; r < 9; ++r) a[r] += wv * sc[r * 1024 + k]; }
#pragma unroll
          for (int r = 0; r < 9; ++r)
#pragma unroll
              for (int i = 0; i < 4; ++i) { float v = a[r][i]; v += __shfl_xor(v, 16); v += __shfl_xor(v, 32); a[r][i] = v; }
          if (rg == 0) {
#pragma unroll
              for (int r = 0; r < 9; ++r)
#pragma unroll
                  for (int i = 0; i < 4; ++i) part[(wid * 9 + r) * 64 + cg * 4 + i] = a[r][i]; }
          __syncthreads();
          for (int o = tid; o < 9 * 64; o += NTHREADS) { const int r = o >> 6, l = o & 63; float s = 0.f;
#pragma unroll
              for (int w8 = 0; w8 < 8; ++w8) s += part[(w8 * 9 + r) * 64 + l];
              const int nn = n0 + l; MOD[(size_t)(layer * 9 + r) * 6144 + nn] = s + p->in[9][layer * 6144 + nn]; }
          __syncthreads();
      } }
}

__device__ void phase_norm(KP p, int layer, int which, int first, int row_lo, int row_hi, int nb, int bi) {
    const int wid = tidx() >> 6, lane = tidx() & 63;
    const float* gp = (which ? p->in[11] : p->in[10]) + layer * 1024;
    const int shift_off = which ? 3072 : 0, scale_off = which ? 4096 : 1024;
    const float* MOD = (const float*)(p->ws + WS_MOD);
    bf16_t* H = (bf16_t*)(p->ws + WS_H);
    for (int row = row_lo + bi * 8 + wid; row < row_hi; row += nb * 8) {
        const float* src = first ? xrow(p->in[0], p->in[1], row) : p->out + (size_t)row * D;
        const int cr = row < TP ? 0 : 1 + ((row - TP) >> 11);
        const float* md = MOD + (size_t)(layer * 9 + cr) * 6144;
        f32x4 v[4]; float ss = 0.f;
#pragma unroll
        for (int i = 0; i < 4; ++i) { v[i] = *(const f32x4*)(src + i * 256 + lane * 4); ss += v[i][0] * v[i][0] + v[i][1] * v[i][1] + v[i][2] * v[i][2] + v[i][3] * v[i][3]; }
        ss = wave_sum(ss); const float rs = rsqrtf(ss * (1.0f / 1024.0f) + EPS);
#pragma unroll
        for (int i = 0; i < 4; ++i) { const int c = i * 256 + lane * 4;
            const f32x4 g = *(const f32x4*)(gp + c), sc = *(const f32x4*)(md + scale_off + c), sh = *(const f32x4*)(md + shift_off + c);
            const f32x4 o = v[i] * rs * g * (sc + 1.0f) + sh;
            u32x2 w; w.x = cvt_pk_bf16(o[0], o[1]); w.y = cvt_pk_bf16(o[2], o[3]); *(u32x2*)(H + (size_t)row * D + c) = w; }
    }
}

__device__ void phase_mla_post_down(KP p) {
    const int wid = tidx() >> 6, lane = tidx() & 63;
    const float* Dn = (const float*)(p->ws + WS_AR + A_DN);
    bf16_t* CQ = (bf16_t*)(p->ws + WS_AR + A_CQ); bf16_t* KVIN = (bf16_t*)(p->ws + WS_AR + A_KVIN); bf16_t* KR = (bf16_t*)(p->ws + WS_AR + A_KR);
    const float* RC = (const float*)(p->ws + WS_ROPE); const float* RS = RC + 65536;
    const float* qn = p->in[13]; const float* kvn = p->in[14]; const float* knr = p->in[21];
    for (int row = bidx() * 8 + wid; row < T; row += gridDim.x * 8) {
        const float* d = Dn + (size_t)row * 1280;
        f32x4 q[3]; float ss = 0.f;
#pragma unroll
        for (int i = 0; i < 3; ++i) { q[i] = *(const f32x4*)(d + i * 256 + lane * 4); ss += q[i][0] * q[i][0] + q[i][1] * q[i][1] + q[i][2] * q[i][2] + q[i][3] * q[i][3]; }
        const f32x4 kv = *(const f32x4*)(d + 768 + lane * 4); float s2 = kv[0] * kv[0] + kv[1] * kv[1] + kv[2] * kv[2] + kv[3] * kv[3];
        const float kr = d[1024 + lane]; float s3 = kr * kr;
#pragma unroll
        for (int o = 32; o >= 1; o >>= 1) { ss += __shfl_xor(ss, o); s2 += __shfl_xor(s2, o); s3 += __shfl_xor(s3, o); }
        const float r1 = rsqrtf(ss * (1.0f / 768.0f) + EPS), r2 = rsqrtf(s2 * (1.0f / 256.0f) + EPS), r3 = rsqrtf(s3 * (1.0f / 64.0f) + EPS);
#pragma unroll
        for (int i = 0; i < 3; ++i) { const int c = i * 256 + lane * 4; const f32x4 o = q[i] * r1 * *(const f32x4*)(qn + c);
            u32x2 w; w.x = cvt_pk_bf16(o[0], o[1]); w.y = cvt_pk_bf16(o[2], o[3]); *(u32x2*)(CQ + (size_t)row * 768 + c) = w; }
        const int kvr = kvrow_of(row);
        { const f32x4 o = kv * r2 * *(const f32x4*)(kvn + lane * 4);
          u32x2 w; w.x = cvt_pk_bf16(o[0], o[1]); w.y = cvt_pk_bf16(o[2], o[3]); *(u32x2*)(KVIN + (size_t)kvr * 256 + lane * 4) = w;
          if (row < TP) *(f32x4*)(p->out + O_CKV + (size_t)row * 256 + lane * 4) = o; }
        { float val = kr * r3 * knr[lane];
          if (row < TP) p->out[O_KR + (size_t)row * 64 + lane] = val;
          else { const int s = (row - TP) & 2047; const float other = __shfl_xor(val, 32); const int f = lane & 31; const float cs = RC[s * 32 + f], sn = RS[s * 32 + f];
                 val = lane < 32 ? val * cs - other * sn : val * cs + other * sn; }
          KR[(size_t)kvr * 64 + lane] = f2bf(val); }
    }
}

__device__ void phase_mla_headprep(KP p) {
    const int wid = tidx() >> 6, lane = tidx() & 63, hq = lane >> 4, l16 = lane & 15;
    bf16_t* Qh = (bf16_t*)(p->ws + WS_AR + A_QH); bf16_t* Kh = (bf16_t*)(p->ws + WS_AR + A_KH); const bf16_t* KR = (const bf16_t*)(p->ws + WS_AR + A_KR);
    const float* RC = (const float*)(p->ws + WS_ROPE); const float* RS = RC + 65536;
    const float qs = 0.07216878364870322f * LOG2E;
    const f32x4 qnn0 = *(const f32x4*)(p->in[18] + 8 * l16), qnn1 = *(const f32x4*)(p->in[18] + 8 * l16 + 4), qnr = *(const f32x4*)(p->in[19] + 4 * l16);
    const f32x4 knn0 = *(const f32x4*)(p->in[20] + 8 * l16), knn1 = *(const f32x4*)(p->in[20] + 8 * l16 + 4);
    const int nw = gridDim.x * 8;
    for (int row = bidx() * 8 + wid; row < T + KVT; row += nw) {
        if (row < T) {
            const bool lat = row >= TP; const int s = (row - TP) & 2047; const int f0 = 4 * (l16 & 7);
            f32x4 cs = (f32x4){1.f, 1.f, 1.f, 1.f}, sn = (f32x4){0.f, 0.f, 0.f, 0.f};
            if (lat) { cs = *(const f32x4*)(RC + s * 32 + f0); sn = *(const f32x4*)(RS + s * 32 + f0); }
            bf16_t* base = Qh + (size_t)row * 1536;
#pragma unroll
            for (int h4 = 0; h4 < 2; ++h4) {
                bf16_t* hb = base + (h4 * 4 + hq) * 192;
                const u32x4 nw4 = *(const u32x4*)(hb + 8 * l16); const u32x2 rw = *(const u32x2*)(hb + 128 + 4 * l16);
                f32x4 a0 = (f32x4){bflo(nw4.x), bfhi(nw4.x), bflo(nw4.y), bfhi(nw4.y)}, a1 = (f32x4){bflo(nw4.z), bfhi(nw4.z), bflo(nw4.w), bfhi(nw4.w)};
                f32x4 r = (f32x4){bflo(rw.x), bfhi(rw.x), bflo(rw.y), bfhi(rw.y)};
                float s1 = a0[0] * a0[0] + a0[1] * a0[1] + a0[2] * a0[2] + a0[3] * a0[3] + a1[0] * a1[0] + a1[1] * a1[1] + a1[2] * a1[2] + a1[3] * a1[3];
                float s2 = r[0] * r[0] + r[1] * r[1] + r[2] * r[2] + r[3] * r[3];
#pragma unroll
                for (int o = 1; o <= 8; o <<= 1) { s1 += __shfl_xor(s1, o); s2 += __shfl_xor(s2, o); }
                const float rn = rsqrtf(s1 * (1.0f / 128.0f) + EPS) * qs, rr = rsqrtf(s2 * (1.0f / 64.0f) + EPS);
                a0 = a0 * rn * qnn0; a1 = a1 * rn * qnn1; r = r * rr * qnr;
                if (lat) { f32x4 ot;
#pragma unroll
                    for (int j = 0; j < 4; ++j) ot[j] = __shfl_xor(r[j], 8);
                    r = l16 < 8 ? r * cs - ot * sn : r * cs + ot * sn; }
                r = r * qs;
                u32x4 ow; ow.x = cvt_pk_bf16(a0[0], a0[1]); ow.y = cvt_pk_bf16(a0[2], a0[3]); ow.z = cvt_pk_bf16(a1[0], a1[1]); ow.w = cvt_pk_bf16(a1[2], a1[3]);
                u32x2 orr; orr.x = cvt_pk_bf16(r[0], r[1]); orr.y = cvt_pk_bf16(r[2], r[3]);
                *(u32x4*)(hb + 8 * l16) = ow; *(u32x2*)(hb + 128 + 4 * l16) = orr;
            }
        } else {
            const int kr = row - T; bf16_t* base = Kh + (size_t)kr * 1536; const u32x2 krv = *(const u32x2*)(KR + (size_t)kr * 64 + 4 * l16);
#pragma unroll
            for (int h4 = 0; h4 < 2; ++h4) {
                bf16_t* hb = base + (h4 * 4 + hq) * 192;
                const u32x4 nw4 = *(const u32x4*)(hb + 8 * l16);
                f32x4 a0 = (f32x4){bflo(nw4.x), bfhi(nw4.x), bflo(nw4.y), bfhi(nw4.y)}, a1 = (f32x4){bflo(nw4.z), bfhi(nw4.z), bflo(nw4.w), bfhi(nw4.w)};
                float s1 = a0[0] * a0[0] + a0[1] * a0[1] + a0[2] * a0[2] + a0[3] * a0[3] + a1[0] * a1[0] + a1[1] * a1[1] + a1[2] * a1[2] + a1[3] * a1[3];
#pragma unroll
                for (int o = 1; o <= 8; o <<= 1) s1 += __shfl_xor(s1, o);
                const float rn = rsqrtf(s1 * (1.0f / 128.0f) + EPS);
                a0 = a0 * rn * knn0; a1 = a1 * rn * knn1;
                u32x4 ow; ow.x = cvt_pk_bf16(a0[0], a0[1]); ow.y = cvt_pk_bf16(a0[2], a0[3]); ow.z = cvt_pk_bf16(a1[0], a1[1]); ow.w = cvt_pk_bf16(a1[2], a1[3]);
                *(u32x4*)(hb + 8 * l16) = ow; *(u32x2*)(hb + 128 + 4 * l16) = krv;
            }
        }
    }
}

__device__ void phase_diff_cache(KP p) {
    const int gtid = bidx() * NTHREADS + tidx(), gn = gridDim.x * NTHREADS;
    bf16_t* Kh = (bf16_t*)(p->ws + WS_AR + D_KH); bf16_t* Vr = (bf16_t*)(p->ws + WS_AR + D_O2);
    for (int i = gtid; i < 8 * 256 * 1024 / 4; i += gn) { const int e = i * 4, c = e & 1023, pp = (e >> 10) & 255, b = e >> 18;
        const f32x4 v = *(const f32x4*)(p->in[4] + e); const f32x4 v2 = *(const f32x4*)(p->in[5] + e);
        u32x2 w; w.x = cvt_pk_bf16(v[0], v[1]); w.y = cvt_pk_bf16(v[2], v[3]); *(u32x2*)(Kh + (size_t)(TP + b * LLAT + pp) * 1024 + c) = w;
        u32x2 w2; w2.x = cvt_pk_bf16(v2[0], v2[1]); w2.y = cvt_pk_bf16(v2[2], v2[3]); *(u32x2*)(Vr + (size_t)(TP + b * LLAT + pp) * 1024 + c) = w2; }
}

__device__ void phase_vtrans(LAS unsigned char* lds, const bf16_t* Vr, bf16_t* VT) {
    const int tid = tidx();
    for (int t = bidx(); t < 352 * 16; t += gridDim.x) {
        const int kt = t >> 4, ec = t & 15, kvrow0 = kt * 64;
        size_t base; int L, key0;
        if (kvrow0 < TP) { const int sq = kvrow0 >> 8; key0 = kvrow0 & 255; L = 256; base = (size_t)sq * (1024 * 256); }
        else { const int r = kvrow0 - TP, sq = r / LLAT; key0 = r - sq * LLAT; L = LLAT; base = (size_t)TP * 1024 + (size_t)sq * (1024 * LLAT); }
        __syncthreads();
        { const int key = tid >> 3, pc = tid & 7; const u32x4 v = *(const u32x4*)(Vr + (size_t)(kvrow0 + key) * 1024 + ec * 64 + pc * 8);
#pragma unroll
          for (int j = 0; j < 4; ++j) { *(LAS bf16_t*)(lds + (pc * 8 + 2 * j) * 144 + key * 2) = (bf16_t)(v[j] & 0xffffu); *(LAS bf16_t*)(lds + (pc * 8 + 2 * j + 1) * 144 + key * 2) = (bf16_t)(v[j] >> 16); } }
        __syncthreads();
        { const int e = tid >> 3, kp = tid & 7, kg = kp >> 2, g4 = kp & 3;
          const u32x2 lo = *(const LAS u32x2*)(lds + e * 144 + (32 * kg + 4 * g4) * 2), hi = *(const LAS u32x2*)(lds + e * 144 + (32 * kg + 16 + 4 * g4) * 2);
          u32x4 w; w.x = lo.x; w.y = lo.y; w.z = hi.x; w.w = hi.y;
          *(u32x4*)(VT + base + (size_t)(ec * 64 + e) * L + key0 + kp * 8) = w; }
    }
}

__device__ void phase_diff_headprep(KP p) {
    const int wid = tidx() >> 6, lane = tidx() & 63, hq = lane >> 4, l16 = lane & 15, d0 = 4 * l16;
    bf16_t* Qh = (bf16_t*)(p->ws + WS_AR + D_QH); bf16_t* Kh = (bf16_t*)(p->ws + WS_AR + D_KH);
    const float* RC = (const float*)(p->ws + WS_ROPE); const float* RS = RC + 65536;
    const float qs = 0.125f * LOG2E; const f32x4 qn = *(const f32x4*)(p->in[24] + d0), kn = *(const f32x4*)(p->in[25] + d0);
    const int nw = gridDim.x * 8;
    for (int it = bidx() * 8 + wid; it < 2 * T; it += nw) {
        const int row = it >> 1, isk = it & 1;
        const bool lat = row >= TP; const int s = (row - TP) & 2047; const int f0 = 4 * (l16 & 7);
        f32x4 cs = (f32x4){1.f, 1.f, 1.f, 1.f}, sn = (f32x4){0.f, 0.f, 0.f, 0.f};
        if (lat) { cs = *(const f32x4*)(RC + s * 32 + f0); sn = *(const f32x4*)(RS + s * 32 + f0); }
        bf16_t* base = isk ? Kh + (size_t)kvrow_of(row) * 1024 : Qh + (size_t)row * 1024;
        const f32x4 gsc = isk ? kn : qn;
#pragma unroll
        for (int h4 = 0; h4 < 4; ++h4) {
            const int hh = h4 * 4 + hq;
            const u32x2 w = *(const u32x2*)(base + hh * 64 + d0);
            f32x4 v = (f32x4){bflo(w.x), bfhi(w.x), bflo(w.y), bfhi(w.y)};
            float ss = v[0] * v[0] + v[1] * v[1] + v[2] * v[2] + v[3] * v[3];
            ss += __shfl_xor(ss, 1); ss += __shfl_xor(ss, 2); ss += __shfl_xor(ss, 4); ss += __shfl_xor(ss, 8);
            const float rs = rsqrtf(ss * (1.0f / 64.0f) + EPS);
            v = v * rs * gsc;
            if (isk && !lat) *(f32x4*)(p->out + O_DK + (size_t)row * 1024 + hh * 64 + d0) = v;
            if (lat) { f32x4 ot;
#pragma unroll
                for (int j = 0; j < 4; ++j) ot[j] = __shfl_xor(v[j], 8);
                v = l16 < 8 ? v * cs - ot * sn : v * cs + ot * sn; }
            if (!isk) v = v * qs;
            u32x2 o; o.x = cvt_pk_bf16(v[0], v[1]); o.y = cvt_pk_bf16(v[2], v[3]);
            *(u32x2*)(base + hh * 64 + d0) = o;
        }
    }
}

__device__ void phase_diff_combine(KP p) {
    const int wid = tidx() >> 6, lane = tidx() & 63, hq = lane >> 4, l16 = lane & 15;
    const bf16_t* O2 = (const bf16_t*)(p->ws + WS_AR + D_O2); bf16_t* H = (bf16_t*)(p->ws + WS_H);
    const float lam_init = 0.8f - 0.6f * expf(-0.3f);
    const float d1 = wave_sum(p->in[26][lane] * p->in[27][lane]), d2 = wave_sum(p->in[28][lane] * p->in[29][lane]);
    const float lam = expf(d1) - expf(d2) + lam_init;
    const f32x4 hn0 = *(const f32x4*)(p->in[30] + 8 * l16) * (1.0f - lam_init), hn1 = *(const f32x4*)(p->in[30] + 8 * l16 + 4) * (1.0f - lam_init);
    for (int row = bidx() * 8 + wid; row < T; row += gridDim.x * 8) {
        const bf16_t* b = O2 + (size_t)row * 2048;
#pragma unroll
        for (int h4 = 0; h4 < 2; ++h4) {
            const int h = h4 * 4 + hq;
            const u32x4 w0 = *(const u32x4*)(b + h * 128 + 8 * l16), w1 = *(const u32x4*)(b + 1024 + h * 128 + 8 * l16);
            f32x4 a0 = (f32x4){bflo(w0.x) - lam * bflo(w1.x), bfhi(w0.x) - lam * bfhi(w1.x), bflo(w0.y) - lam * bflo(w1.y), bfhi(w0.y) - lam * bfhi(w1.y)};
            f32x4 a1 = (f32x4){bflo(w0.z) - lam * bflo(w1.z), bfhi(w0.z) - lam * bfhi(w1.z), bflo(w0.w) - lam * bflo(w1.w), bfhi(w0.w) - lam * bfhi(w1.w)};
            float ss = a0[0] * a0[0] + a0[1] * a0[1] + a0[2] * a0[2] + a0[3] * a0[3] + a1[0] * a1[0] + a1[1] * a1[1] + a1[2] * a1[2] + a1[3] * a1[3];
            ss += __shfl_xor(ss, 1); ss += __shfl_xor(ss, 2); ss += __shfl_xor(ss, 4); ss += __shfl_xor(ss, 8);
            const float rs = rsqrtf(ss * (1.0f / 128.0f) + EPS);
            a0 = a0 * rs * hn0; a1 = a1 * rs * hn1;
            u32x4 o; o.x = cvt_pk_bf16(a0[0], a0[1]); o.y = cvt_pk_bf16(a0[2], a0[3]); o.z = cvt_pk_bf16(a1[0], a1[1]); o.w = cvt_pk_bf16(a1[2], a1[3]);
            *(u32x4*)(H + (size_t)row * D + h * 128 + 8 * l16) = o;
        }
    }
}

__device__ void phase_sconv_ew(KP p) {
    const int gtid = bidx() * NTHREADS + tidx(), gn = gridDim.x * NTHREADS;
    const bf16_t* S3 = (const bf16_t*)(p->ws + WS_AR); bf16_t* H = (bf16_t*)(p->ws + WS_H); const float* cw = p->in[33];
    for (int i = gtid; i < T * 128; i += gn) {
        const int t = i >> 7, c0 = (i & 127) * 8;
        int pos, len; if (t < TP) { pos = t & 255; len = 256; } else { pos = (t - TP) & 2047; len = 2048; }
        const bf16_t* r = S3 + (size_t)t * 3072;
        const u32x4 gb = *(const u32x4*)(r + c0);
        float pm[8], pc[8], pn[8];
        { const u32x4 a = *(const u32x4*)(r + 1024 + c0), b = *(const u32x4*)(r + 2048 + c0);
#pragma unroll
          for (int j = 0; j < 4; ++j) { pc[2 * j] = bflo(a[j]) * bflo(b[j]); pc[2 * j + 1] = bfhi(a[j]) * bfhi(b[j]); } }
        if (pos > 0) { const u32x4 a = *(const u32x4*)(r - 3072 + 1024 + c0), b = *(const u32x4*)(r - 3072 + 2048 + c0);
#pragma unroll
            for (int j = 0; j < 4; ++j) { pm[2 * j] = bflo(a[j]) * bflo(b[j]); pm[2 * j + 1] = bfhi(a[j]) * bfhi(b[j]); } }
        else {
#pragma unroll
            for (int j = 0; j < 8; ++j) pm[j] = 0.f; }
        if (pos < len - 1) { const u32x4 a = *(const u32x4*)(r + 3072 + 1024 + c0), b = *(const u32x4*)(r + 3072 + 2048 + c0);
#pragma unroll
            for (int j = 0; j < 4; ++j) { pn[2 * j] = bflo(a[j]) * bflo(b[j]); pn[2 * j + 1] = bfhi(a[j]) * bfhi(b[j]); } }
        else {
#pragma unroll
            for (int j = 0; j < 8; ++j) pn[j] = 0.f; }
        float o[8];
#pragma unroll
        for (int j = 0; j < 8; ++j) { const float g = (j & 1) ? bfhi(gb[j >> 1]) : bflo(gb[j >> 1]);
            o[j] = g * (cw[c0 + j] * pm[j] + cw[1024 + c0 + j] * pc[j] + cw[2048 + c0 + j] * pn[j]); }
        u32x4 w; w.x = cvt_pk_bf16(o[0], o[1]); w.y = cvt_pk_bf16(o[2], o[3]); w.z = cvt_pk_bf16(o[4], o[5]); w.w = cvt_pk_bf16(o[6], o[7]);
        *(u32x4*)(H + (size_t)t * D + c0) = w;
    }
}

__device__ void phase_gmlp_spatial(KP p, LAS unsigned char* lds) {
    const int tid = tidx(), wid = tid >> 6, lane = tid & 63, gq = lane >> 4, c = lane & 15;
    const bf16_t* UV = (const bf16_t*)(p->ws + WS_AR); bf16_t* H = (bf16_t*)(p->ws + WS_H);
    const bf16_t* WS_ = (const bf16_t*)(p->ws + WS_W) + OW_GS;
    const float* vn = p->in[36]; const float* bs = p->in[38];
    LAS float* rq = (LAS float*)lds;
    LAS unsigned char* vt = lds + 1024;
    for (int unit = bidx(); unit < 160 * 8; unit += gridDim.x) {
        const int ck = unit >> 3, g = unit & 7, t0 = ck * 128;
        __syncthreads();
        if (tid < 128) rq[tid] = rsqrtf(((const float*)(p->ws + WS_GST))[t0 + tid] * (1.0f / 1024.0f) + EPS);
        __syncthreads();
#pragma unroll
        for (int i = 0; i < 4; ++i) { const int idx = tid + 512 * i, q = idx & 127, pc = idx >> 7;
            const u32x4 a = *(const u32x4*)(UV + (size_t)(t0 + q) * 2048 + 1024 + g * 128 + pc * 8); const float r = rq[q];
#pragma unroll
            for (int j = 0; j < 4; ++j) { const int e = pc * 8 + 2 * j;
                *(LAS bf16_t*)(vt + e * 272 + q * 2) = f2bf(bflo(a[j]) * r * vn[g * 128 + e]);
                *(LAS bf16_t*)(vt + (e + 1) * 272 + q * 2) = f2bf(bfhi(a[j]) * r * vn[g * 128 + e + 1]); } }
        __syncthreads();
        f32x4 acc[8];
#pragma unroll
        for (int et = 0; et < 8; ++et) acc[et] = (f32x4){0.f, 0.f, 0.f, 0.f};
        const int pp = wid * 16 + c;
#pragma unroll
        for (int ks = 0; ks < 4; ++ks) {
            const bf16x8 bfr = *(const bf16x8*)(WS_ + (size_t)(g * 128 + pp) * 128 + ks * 32 + gq * 8);
#pragma unroll
            for (int et = 0; et < 8; ++et) { const bf16x8 afr = *(const LAS bf16x8*)(vt + (et * 16 + c) * 272 + (ks * 32 + gq * 8) * 2);
                acc[et] = __builtin_amdgcn_mfma_f32_16x16x32_bf16(afr, bfr, acc[et], 0, 0, 0); }
        }
        const float bias = bs[g * 128 + pp]; const int tok = t0 + pp;
#pragma unroll
        for (int et = 0; et < 8; ++et) { const int e = g * 128 + et * 16 + 4 * gq; const u32x2 uu = *(const u32x2*)(UV + (size_t)tok * 2048 + e);
            u32x2 w; w.x = cvt_pk_bf16(bflo(uu.x) * (acc[et][0] + bias), bfhi(uu.x) * (acc[et][1] + bias)); w.y = cvt_pk_bf16(bflo(uu.y) * (acc[et][2] + bias), bfhi(uu.y) * (acc[et][3] + bias));
            *(u32x2*)(H + (size_t)tok * D + e) = w; }
    }
}

__device__ void ffn_fix_panel(KP p, int layer, int pm) {
    const float* __restrict__ HALO = (const float*)(p->ws + WS_AR + F_HALO); bf16_t* __restrict__ ACT = (bf16_t*)(p->ws + WS_AR + F_ACT);
    const float* __restrict__ cw = p->in[41] + (size_t)layer * 3 * 5632; const float* __restrict__ cb = p->in[42] + (size_t)layer * 5632;
#pragma unroll 2
    for (int i = tidx(); i < 4 * 704; i += NTHREADS) {
        const int e = i / 704, ch = (i - e * 704) * 4, eg = 4 * pm + e, run = eg >> 1, lastt = eg & 1;
        const int tok = run * 128 + (lastt ? 127 : 0);
        int pos, len; if (tok < TP) { pos = tok & 255; len = 256; } else { pos = (tok - TP) & 2047; len = 2048; }
        const float* hr = HALO + (size_t)(run * 4) * 5632;
        const f32x4 z = (f32x4){0.f, 0.f, 0.f, 0.f};
        f32x4 gp, gc, gnx, up, uc, unx;
        if (!lastt) { gc = *(const f32x4*)(hr + ch); uc = *(const f32x4*)(hr + 2816 + ch); gnx = *(const f32x4*)(hr + 5632 + ch); unx = *(const f32x4*)(hr + 5632 + 2816 + ch);
            if (pos > 0) { gp = *(const f32x4*)(hr - 5632 + ch); up = *(const f32x4*)(hr - 5632 + 2816 + ch); } else { gp = z; up = z; } }
        else { gp = *(const f32x4*)(hr + 2 * 5632 + ch); up = *(const f32x4*)(hr + 2 * 5632 + 2816 + ch); gc = *(const f32x4*)(hr + 3 * 5632 + ch); uc = *(const f32x4*)(hr + 3 * 5632 + 2816 + ch);
            if (pos < len - 1) { gnx = *(const f32x4*)(hr + 4 * 5632 + ch); unx = *(const f32x4*)(hr + 4 * 5632 + 2816 + ch); } else { gnx = z; unx = z; } }
        const f32x4 cg = *(const f32x4*)(cw + ch) * gp + *(const f32x4*)(cw + 5632 + ch) * gc + *(const f32x4*)(cw + 11264 + ch) * gnx + *(const f32x4*)(cb + ch);
        const f32x4 cu = *(const f32x4*)(cw + 2816 + ch) * up + *(const f32x4*)(cw + 5632 + 2816 + ch) * uc + *(const f32x4*)(cw + 11264 + 2816 + ch) * unx + *(const f32x4*)(cb + 2816 + ch);
        u32x2 w; w.x = cvt_pk_bf16(silu_f(cg[0]) * cu[0], silu_f(cg[1]) * cu[1]); w.y = cvt_pk_bf16(silu_f(cg[2]) * cu[2], silu_f(cg[3]) * cu[3]);
        *(u32x2*)(ACT + (size_t)tok * 2816 + ch) = w;
    }
}

template <int DQK, int QT, int KEYS>
__device__ __forceinline__ void attn_unit(LAS unsigned char* lds, const bf16_t* Qp, int qstride, const bf16_t* Kp, int kstride, const bf16_t* VTp, int L, bf16_t* Op, int ostride, int nq) {
    constexpr int KBYTES = KEYS * DQK * 2, VBYTES = 128 * KEYS * 2, STAGE = KBYTES + VBYTES, VG = KEYS / 32;
    constexpr int KPC = DQK / 8, NKP = 64 * KPC / 512, NKS = DQK / 32;
    const int tid = tidx(), wid = tid >> 6, lane = tid & 63, g = lane >> 4, c = lane & 15;
    const int q0 = wid * 16 * QT;
    const int fbase = c * 64 + ((g << 4) ^ ((c >> 3) << 5));
    const bool active = __builtin_amdgcn_readfirstlane(q0) < nq;
    bf16x8 qf[QT][NKS];
#pragma unroll
    for (int qt = 0; qt < QT; ++qt)
#pragma unroll
        for (int ks = 0; ks < NKS; ++ks) qf[qt][ks] = active ? *(const bf16x8*)(Qp + (size_t)(q0 + qt * 16 + c) * qstride + ks * 32 + g * 8) : (bf16x8){0, 0, 0, 0, 0, 0, 0, 0};
    f32x4 o[QT][8];
#pragma unroll
    for (int qt = 0; qt < QT; ++qt)
#pragma unroll
        for (int et = 0; et < 8; ++et) o[qt][et] = (f32x4){0.f, 0.f, 0.f, 0.f};
    float lsum[QT];
#pragma unroll
    for (int qt = 0; qt < QT; ++qt) lsum[qt] = 0.f;
    const int nt = L / KEYS;
    constexpr int NKD = (KEYS / 16) * NKS / 8, NVD = 8 * VG / 8;
    const int wv = __builtin_amdgcn_readfirstlane(wid);
    const int drr = lane >> 2, dlp = (lane & 3) ^ ((drr >> 3) << 1);
    unsigned kdo[NKD], vdo[NVD];
#pragma unroll
    for (int i_ = 0; i_ < NKD; ++i_) { const int st_ = wv + 8 * i_, rg_ = st_ / NKS, cs_ = st_ % NKS; kdo[i_] = (unsigned)((rg_ * 16 + drr) * kstride + (cs_ * 4 + dlp) * 8) * 2u; }
#pragma unroll
    for (int i_ = 0; i_ < NVD; ++i_) { const int st_ = wv + 8 * i_, eg_ = st_ / VG, k2_ = st_ % VG; vdo[i_] = (unsigned)((eg_ * 16 + drr) * L + (k2_ * 4 + dlp) * 8) * 2u; }
#define ATT_DMA(t, stg) do { const char* kt_ = (const char*)(Kp + (size_t)(t) * KEYS * kstride); const char* vt_ = (const char*)(VTp + (t) * KEYS); \
        _Pragma("unroll") for (int i_ = 0; i_ < NKD; ++i_) __builtin_amdgcn_global_load_lds((const unsigned*)(kt_ + kdo[i_]), (LAS unsigned*)(lds + (stg) * STAGE + (wv + 8 * i_) * 1024), 16, 0, 0); \
        _Pragma("unroll") for (int i_ = 0; i_ < NVD; ++i_) __builtin_amdgcn_global_load_lds((const unsigned*)(vt_ + vdo[i_]), (LAS unsigned*)(lds + (stg) * STAGE + KBYTES + (wv + 8 * i_) * 1024), 16, 0, 0); } while (0)
    __syncthreads();
    ATT_DMA(0, 0);
    asm volatile("s_waitcnt vmcnt(0)" ::: "memory");
    __syncthreads();
    for (int t = 0; t < nt; ++t) {
        if (t + 1 < nt) ATT_DMA(t + 1, (t + 1) & 1);
        LAS unsigned char* kb = lds + (t & 1) * STAGE; LAS unsigned char* vb = kb + KBYTES;
        if (active) {
#pragma unroll 1
            for (int k2 = 0; k2 < VG; ++k2) {
                LAS unsigned char* kg = kb + k2 * (2 * NKS * 1024); LAS unsigned char* vg = vb + k2 * 1024;
                f32x4 s[QT][2];
#pragma unroll
                for (int qt = 0; qt < QT; ++qt) { s[qt][0] = (f32x4){0.f, 0.f, 0.f, 0.f}; s[qt][1] = (f32x4){0.f, 0.f, 0.f, 0.f}; }
#pragma unroll
                for (int kk = 0; kk < 2; ++kk)
#pragma unroll
                    for (int ks = 0; ks < NKS; ++ks) { const bf16x8 kf = *(const LAS bf16x8*)(kg + fbase + (kk * NKS + ks) * 1024);
#pragma unroll
                        for (int qt = 0; qt < QT; ++qt) s[qt][kk] = __builtin_amdgcn_mfma_f32_16x16x32_bf16(kf, qf[qt][ks], s[qt][kk], 0, 0, 0); }
                bf16x8 pb[QT];
#pragma unroll
                for (int qt = 0; qt < QT; ++qt) {
#pragma unroll
                    for (int i = 0; i < 4; ++i) { s[qt][0][i] = __builtin_amdgcn_exp2f(s[qt][0][i]); s[qt][1][i] = __builtin_amdgcn_exp2f(s[qt][1][i]); }
                    const f32x4 ps4 = s[qt][0] + s[qt][1]; lsum[qt] += (ps4[0] + ps4[1]) + (ps4[2] + ps4[3]);
                    u32x4 w; w.x = cvt_pk_bf16_mf(s[qt][0][0], s[qt][0][1]); w.y = cvt_pk_bf16_mf(s[qt][0][2], s[qt][0][3]); w.z = cvt_pk_bf16_mf(s[qt][1][0], s[qt][1][1]); w.w = cvt_pk_bf16_mf(s[qt][1][2], s[qt][1][3]);
                    pb[qt] = __builtin_bit_cast(bf16x8, w); }
#pragma unroll
                for (int et = 0; et < 8; ++et) { const bf16x8 vf = *(const LAS bf16x8*)(vg + fbase + (et * VG) * 1024);
#pragma unroll
                    for (int qt = 0; qt < QT; ++qt) o[qt][et] = __builtin_amdgcn_mfma_f32_16x16x32_bf16(vf, pb[qt], o[qt][et], 0, 0, 0); }
            }
        }
        asm volatile("s_waitcnt vmcnt(0)" ::: "memory");
        __syncthreads();
    }
#undef ATT_DMA
    if (active) {
#pragma unroll
        for (int qt = 0; qt < QT; ++qt) {
            float l = lsum[qt]; l += __shfl_xor(l, 16); l += __shfl_xor(l, 32); const float inv = 1.0f / l;
            bf16_t* orow = Op + (size_t)(q0 + qt * 16 + c) * ostride + 4 * g;
#pragma unroll
            for (int et = 0; et < 8; ++et) { const f32x4 v = o[qt][et] * inv; u32x2 w; w.x = cvt_pk_bf16(v[0], v[1]); w.y = cvt_pk_bf16(v[2], v[3]); *(u32x2*)(orow + et * 16) = w; }
        }
    }
}

template <int DQK, int QT, int KEYS>
__device__ void phase_attn(LAS unsigned char* lds, const bf16_t* Qh, const bf16_t* Kh, const bf16_t* VT, bf16_t* O, int nh, int stride, int ostride) {
    constexpr int QB = 128 * QT, NQB = 2048 / QB;
    const int nlat = 8 * nh * NQB, ntot = nlat + 16 * nh;
    for (int u = bidx(); u < ntot; u += gridDim.x) {
        int h, tok0, kv0, L, nq; size_t vtb;
        if (u < nlat) { const int qb = u % NQB; h = (u / NQB) % nh; const int b = (u / NQB) / nh; tok0 = TP + b * 2048 + qb * QB; kv0 = TP + b * LLAT; L = LLAT; nq = QB;
            vtb = (size_t)TP * 1024 + (size_t)b * (1024 * LLAT) + (size_t)(h & 7) * 128 * LLAT; }
        else { const int v = u - nlat; h = v % nh; const int b = v / nh; tok0 = b * 256; kv0 = tok0; L = 256; nq = 256; vtb = (size_t)b * (1024 * 256) + (size_t)(h & 7) * 128 * 256; }
        attn_unit<DQK, QT, KEYS>(lds, Qh + (size_t)tok0 * stride + h * DQK, stride, Kh + (size_t)kv0 * stride + h * DQK, stride, VT + vtb, L, O + (size_t)tok0 * ostride + h * 128, ostride, nq);
    }
}


#define XB_TMO      128
#define XB_XCNT(j)  (256  + 64 * (j))
#define XB_XSUB(j)  (1280 + 64 * (j))
#define XB_XGEN(j)  (2304 + 64 * (j))
#define XB_TOP      3328
#define XB_TOPGEN   3392
#define XCD_BAR_WORDS 3456
#define XB_SPIN_CAP (1u << 22)
__device__ __forceinline__ unsigned xb_ld(unsigned* p)              { return __hip_atomic_load(p, __ATOMIC_RELAXED, __HIP_MEMORY_SCOPE_AGENT); }
__device__ __forceinline__ unsigned xb_add(unsigned* p, unsigned v) { return __hip_atomic_fetch_add(p, v, __ATOMIC_RELAXED, __HIP_MEMORY_SCOPE_AGENT); }
__device__ __forceinline__ unsigned xb_xcc_id() { return (unsigned)__builtin_amdgcn_s_getreg((3 << 11) | 20) & 0xFu; }
#define XB_SPIN(cond, bar) do { unsigned _sp = 0; while (cond) { __builtin_amdgcn_s_sleep(1); \
    if ((++_sp & 255u) == 0u) { if (xb_ld(&(bar)[XB_TMO])) break; if (_sp > XB_SPIN_CAP) { atomicAdd(&(bar)[XB_TMO], 1u); break; } } } } while (0)
struct XcdBarrier { unsigned* bar; unsigned x; volatile LAS unsigned* st; };
__device__ __forceinline__ XcdBarrier xcd_barrier_post(unsigned* bar, volatile LAS unsigned* st) {
    XcdBarrier b; b.bar = bar; b.x = xb_xcc_id(); b.st = st;
    if (threadIdx.x == 0) (void)xb_add(&bar[XB_XCNT(b.x)], 1u);
    return b;
}
__device__ __forceinline__ void xcd_barrier_complete(unsigned* bar, unsigned x, unsigned& nloc, unsigned& nx) {
    const unsigned G = gridDim.x * gridDim.y * gridDim.z;
    unsigned sum, cnt, mine, sp = 0u;
    for (;;) {
        sum = 0u; cnt = 0u; mine = 0u;
#pragma unroll
        for (unsigned j = 0; j < 16; ++j) { const unsigned c = xb_ld(&bar[XB_XCNT(j)]); sum += c; cnt += (c > 0u) ? 1u : 0u; mine = (j == x) ? c : mine; }
        if (sum == G) break;
        __builtin_amdgcn_s_sleep(1);
        if ((++sp & 255u) == 0u) { if (xb_ld(&bar[XB_TMO])) break; if (sp > XB_SPIN_CAP) { atomicAdd(&bar[XB_TMO], 1u); break; } }
    }
    nloc = mine > 0u ? mine : 1u; nx = cnt > 0u ? cnt : 1u;
}
__device__ __forceinline__ void xcd_barrier(const XcdBarrier& b) {
    asm volatile("s_waitcnt vmcnt(0)" ::: "memory");
    __syncthreads();
    if (threadIdx.x == 0) {
        unsigned* bar = b.bar;
        __builtin_amdgcn_s_waitcnt(0);
        unsigned nloc = b.st[0], nx = b.st[1];
        if (nloc == 0u) { xcd_barrier_complete(bar, b.x, nloc, nx); b.st[0] = nloc; b.st[1] = nx; }
        const unsigned old = xb_add(&bar[XB_XSUB(b.x)], 1u);
        const unsigned gen = old / nloc;
        if (old + 1u == (gen + 1u) * nloc) {
            __builtin_amdgcn_fence(__ATOMIC_RELEASE, "agent");
            asm volatile("s_waitcnt vmcnt(0)" ::: "memory");
            const unsigned og = xb_add(&bar[XB_TOP], 1u);
            const unsigned tg = og / nx;
            if (og + 1u == (tg + 1u) * nx) xb_add(&bar[XB_TOPGEN], 1u);
            else XB_SPIN(xb_ld(&bar[XB_TOPGEN]) == tg, bar);
            __builtin_amdgcn_fence(__ATOMIC_ACQUIRE, "agent");
            xb_add(&bar[XB_XGEN(b.x)], 1u);
            asm volatile("s_waitcnt vmcnt(0)" ::: "memory");
        } else {
            XB_SPIN(xb_ld(&bar[XB_XGEN(b.x)]) == gen, bar);
            __builtin_amdgcn_fence(__ATOMIC_ACQUIRE, "agent");
            asm volatile("s_waitcnt vmcnt(0)" ::: "memory");
        }
    }
    __syncthreads();
}

enum { K_P0 = 0, K_NORM1 = 1, K_GDOWN = 2, K_POSTDOWN = 3, K_GUQKV = 4, K_MLAPREP = 5, K_ATT192 = 6, K_GO = 7, K_GO2 = 8,
       K_NORM1D = 9, K_GQKV = 10, K_DPREP = 11, K_ATT64 = 12, K_DCOMB = 13, K_GSIN = 15, K_SCONV = 16, K_GGIN = 19, K_GMLP = 20,
       K_NORM2 = 22, K_GFFN = 23, K_GFFNOUT = 24, K_GFFNOUT2 = 25 };
constexpr int NPHASES = 42;
__device__ __forceinline__ void decode_phase(int ph, int& kind, int& layer) {
    if (ph == 0) { kind = K_P0; layer = 0; return; }
    int i;
    if (ph < 13) { layer = 0; i = ph - 1; if (i < 8) { kind = 1 + i; return; } i -= 8; }
    else if (ph < 24) { layer = 1; i = ph - 13; if (i < 7) { kind = i < 5 ? 9 + i : (i == 5 ? K_GO : K_GO2); return; } i -= 7; }
    else if (ph < 33) { layer = 2; i = ph - 24; if (i < 5) { kind = i == 0 ? K_NORM1 : (i == 1 ? K_GSIN : (i == 2 ? K_SCONV : (i == 3 ? K_GO : K_GO2))); return; } i -= 5; }
    else { layer = 3; i = ph - 33; if (i < 5) { kind = i == 0 ? K_NORM1 : (i == 1 ? K_GGIN : (i == 2 ? K_GMLP : (i == 3 ? K_GO : K_GO2))); return; } i -= 5; }
    kind = K_NORM2 + i;
}
#ifndef ENMASK
#define ENMASK 0xffffffffffffffffull
#endif
#define EN(k) ((ENMASK >> (k)) & 1ull)
#ifndef DUP_MASK
#define DUP_MASK 0ull
#endif
#ifndef ATT64_QT
#define ATT64_QT 4
#endif
#ifndef EXTRA_SYNCS
#define EXTRA_SYNCS 0
#endif

__global__ void __launch_bounds__(NTHREADS) mega(Params p_, int lo, int hi) {
    extern __shared__ __attribute__((aligned(16))) unsigned char smem[];
    LAS unsigned char* lds = (LAS unsigned char*)smem;
    cg::grid_group grid = cg::this_grid();
    const int G = gridDim.x, bid = bidx();
    volatile LAS unsigned* xst = (volatile LAS unsigned*)(lds + 131072);
    if (threadIdx.x < 4) xst[threadIdx.x] = 0u;
    __syncthreads();
    const XcdBarrier xbar = xcd_barrier_post((unsigned*)(p_.ws + WS_BAR), xst);
    if (hi < 0) grid.sync();
#define SEAM(first_) do { xcd_barrier(xbar); } while (0)
#define GEMM(EpiT, Aptr, Bptr, M_, N_, K_, ...) do { pg8::Gemm g_{(Aptr), (Bptr), (M_), (N_), (K_)}; pg8::StaticOrder S_; S_.init((M_), (N_), G, bid); EpiT E_{__VA_ARGS__}; pg8::gemm_phase<EpiT, pg8::StaticOrder>(lds, g_, S_, E_); } while (0)
    for (int ph = lo; ph < hi; ++ph) {
        int kind, layer; decode_phase(ph, kind, layer);
        KP p = (KP)__builtin_amdgcn_kernarg_segment_ptr(); asm volatile("" : "+s"(p));
        bf16_t* W = (bf16_t*)(p->ws + WS_W);
        bf16_t* H = (bf16_t*)(p->ws + WS_H);
        unsigned char* AR = p->ws + WS_AR;
        const float* MOD = (const float*)(p->ws + WS_MOD);
        const bool dup = (DUP_MASK >> ph) & 1ull; const bool fast = (G == 256);
        for (int rep = 0; rep < (dup ? 2 : 1); ++rep) {
        float* Yo = (dup && rep == 0) ? (float*)(AR + F_HALO + 14417920) : p->out;
        switch (kind) {
        case K_P0: if (EN(0)) phase0(p, lds); break;
        case K_NORM1: if (EN(1)) phase_norm(p, layer, 0, layer == 0, (fast && layer > 0) ? 16384 : 0, T, G, bid); break;
        case K_NORM1D: if (EN(1)) { phase_norm(p, layer, 0, 0, fast ? 16384 : 0, T, G, bid); phase_diff_cache(p); } break;
        case K_NORM2: if (EN(1)) phase_norm(p, layer, 1, 0, fast ? 16384 : 0, T, G, bid); break;
        case K_GDOWN: if (EN(2)) GEMM(EpiF32Plain, H, W + OW_DOWN, T, 1280, 1024, (float*)(AR + A_DN), 1280); break;
        case K_POSTDOWN: if (EN(3)) phase_mla_post_down(p); break;
        case K_GUQKV: case K_GSIN: {
            const bool uq = kind == K_GUQKV;
            if (EN(4)) GEMM(EpiBf16<0>, uq ? (const bf16_t*)(AR + A_CQ) : (const bf16_t*)H, W + (uq ? OW_UQ : OW_SIN), T, uq ? 1536 : 3072, uq ? 768 : 1024, uq ? (bf16_t*)(AR + A_QH) : (bf16_t*)AR, uq ? 1536 : 3072, (float*)nullptr, 0);
            if (uq && EN(5)) GEMM(EpiKV, (const bf16_t*)(AR + A_KVIN), W + OW_UKV, KVT, 2048, 256, (bf16_t*)(AR + A_KH), H);
        } break;
        case K_MLAPREP: if (EN(6)) { phase_mla_headprep(p); phase_vtrans(lds, H, (bf16_t*)(AR + A_VT)); } break;
        case K_ATT192: if (EN(7)) phase_attn<192, 2, 64>(lds, (const bf16_t*)(AR + A_QH), (const bf16_t*)(AR + A_KH), (const bf16_t*)(AR + A_VT), H, 8, 1536, 1024); break;
        case K_GO: case K_GFFNOUT: case K_GO2: case K_GFFNOUT2: {
            const bool f = (kind == K_GFFNOUT || kind == K_GFFNOUT2), r2 = (kind == K_GO2 || kind == K_GFFNOUT2);
            const size_t woff = f ? OW_FFN + (size_t)layer * FFN_STRIDE + FIN_ELEMS : (layer == 0 ? OW_OMLA : (layer == 1 ? OW_ODIFF : (layer == 2 ? OW_SOUT : OW_GOUT)));
            const bf16_t* Ap = f ? (const bf16_t*)(AR + F_ACT) : (const bf16_t*)H; const int Kd = f ? 2816 : 1024;
            const float* gatep = MOD + (size_t)(layer * 9) * 6144 + (f ? 5120 : 2048); const int frst = (!f && layer == 0) ? 1 : 0;
            if (fast) {
                pg8::PanelOrder S_; S_.c = bid; S_.round = r2 ? 1 : 0; Unit u0;
                if (S_.next(0, u0)) {
                    if (f) { ffn_fix_panel(p, layer, u0.pm); asm volatile("s_waitcnt vmcnt(0)" ::: "memory"); __syncthreads(); }
                    pg8::Gemm g_{Ap, W + woff, T, 1024, Kd}; EpiResid E_{p->in[0], p->in[1], p->out, p->out, gatep, frst};
                    if (EN(8)) pg8::gemm_phase<EpiResid, pg8::PanelOrder>(lds, g_, S_, E_);
                } else if (r2) {
                    if (!(f && layer == 3)) phase_norm(p, f ? layer + 1 : layer, f ? 0 : 1, 0, 0, 16384, G - 64, bid - 64);
                    if (layer < 3 && f) { conv_next(p, lds, layer + 1, 0, G - 64, bid - 64); conv_next(p, lds, layer + 1, 1, G - 64, bid - 64); }
                }
            } else if (!r2) {
                if (f) { pg8::StaticOrder S0; S0.init(T, 1024, G, bid); Unit u0;
                    for (int i = 0; S0.next(i, u0); ++i) ffn_fix_panel(p, layer, u0.pm);
                    asm volatile("s_waitcnt vmcnt(0)" ::: "memory"); __syncthreads(); }
                if (EN(8)) GEMM(EpiResid, Ap, W + woff, T, 1024, Kd, p->in[0], p->in[1], p->out, p->out, gatep, frst);
                if (layer < 3) conv_next(p, lds, layer + 1, f ? 1 : 0, G, bid);
            }
        } break;
        case K_GQKV: if (EN(9)) GEMM(EpiQKV, H, W + OW_QKV, T, 3072, 1024, (bf16_t*)(AR + D_QH), (bf16_t*)(AR + D_KH), (bf16_t*)(AR + D_O2), p->out + O_DV); break;
        case K_DPREP: if (EN(10)) { phase_diff_headprep(p); phase_vtrans(lds, (const bf16_t*)(AR + D_O2), (bf16_t*)(AR + D_VT)); } break;
        case K_ATT64: if (EN(11)) phase_attn<64, ATT64_QT, 128>(lds, (const bf16_t*)(AR + D_QH), (const bf16_t*)(AR + D_KH), (const bf16_t*)(AR + D_VT), (bf16_t*)(AR + D_O2), 16, 1024, 2048); break;
        case K_DCOMB: if (EN(12)) phase_diff_combine(p); break;
        case K_SCONV: if (EN(13)) phase_sconv_ew(p); break;
        case K_GGIN: if (EN(14)) GEMM(EpiBf16<1>, H, W + OW_GIN, T, 2048, 1024, (bf16_t*)AR, 2048, (float*)(p->ws + WS_GST), 4); break;
        case K_GMLP: if (EN(15)) phase_gmlp_spatial(p, lds); break;
        case K_GFFN: if (EN(16)) GEMM(EpiFFN, H, W + OW_FFN + (size_t)layer * FFN_STRIDE, T, 5632, 1024, (bf16_t*)(AR + F_ACT), (float*)(AR + F_HALO), p->in[41] + (size_t)layer * 3 * 5632, p->in[42] + (size_t)layer * 5632); break;
        default: break;
        }
        if (dup && rep == 0) SEAM(0);
        }
        if (ph == 0) for (int e = 0; e < EXTRA_SYNCS; ++e) SEAM(0);
        if (ph + 1 < hi) SEAM(ph == lo);
    }
}

extern "C" void kernel_launch(void* const* d_in, const int* in_sizes, int n_in, void* d_out, int out_size, void* d_ws, size_t ws_size, hipStream_t stream) {
    static int grid_blocks = 0;
    if (!grid_blocks) {
        if (n_in != 44 || ws_size < WS_END) { fprintf(stderr, "kernel_launch: unexpected n_in %d / ws_size %zu (need %zu)\n", n_in, ws_size, (size_t)WS_END); }
        int dev = 0, cus = 0, per_cu = 0;
        hipGetDevice(&dev);
        hipDeviceGetAttribute(&cus, hipDeviceAttributeMultiprocessorCount, dev);
        hipFuncSetAttribute((const void*)mega, hipFuncAttributeMaxDynamicSharedMemorySize, LDS_BYTES);
        hipOccupancyMaxActiveBlocksPerMultiprocessor(&per_cu, (const void*)mega, NTHREADS, LDS_BYTES);
        if (per_cu < 1) per_cu = 1;
        grid_blocks = cus * per_cu;
        (void)hipGetLastError();
    }
    Params p{};
    for (int i = 0; i < 44; ++i) p.in[i] = (const float*)d_in[i];
    p.out = (float*)d_out; p.ws = (unsigned char*)d_ws;
    (void)hipMemsetAsync((unsigned char*)d_ws + WS_BAR, 0, XCD_BAR_WORDS * 4, stream);
    int lo = 0, hi = NPHASES;
    void* args[] = {&p, &lo, &hi};
    hipError_t e = hipLaunchCooperativeKernel((const void*)mega, dim3(grid_blocks), dim3(NTHREADS), args, LDS_BYTES, stream);
    if (e != hipSuccess) fprintf(stderr, "cooperative launch failed: %s (grid %d)\n", hipGetErrorString(e), grid_blocks);
}
```

```cpp
#include <hip/hip_runtime.h>
#include <hip/hip_cooperative_groups.h>
#include <cstdio>
namespace cg = cooperative_groups;

#define LAS __attribute__((address_space(3)))
typedef unsigned short bf16_t;
typedef short bf16x8 __attribute__((ext_vector_type(8)));
typedef float f32x4 __attribute__((ext_vector_type(4)));
typedef unsigned u32x4 __attribute__((ext_vector_type(4)));
typedef unsigned u32x2 __attribute__((ext_vector_type(2)));

#ifndef SYNC_MODE
#define SYNC_MODE 1
#endif

constexpr int T = 20480, TP = 4096, D = 1024, KVT = 22528, LLAT = 2304;
constexpr int NTHREADS = 512;
constexpr int LDS_BYTES = 131072 + 64;
constexpr float EPS = 1e-6f;
constexpr float LOG2E = 1.4426950408889634f;

constexpr size_t OW_DOWN = 0, OW_UQ = 1310720, OW_UKV = 2490368, OW_OMLA = 3014656, OW_QKV = 4063232, OW_ODIFF = 7208960,
                 OW_SIN = 8257536, OW_SOUT = 11403264, OW_GIN = 12451840, OW_GS = 14548992, OW_GOUT = 14680064, OW_FFN = 15728640,
                 FFN_STRIDE = 8650752, FIN_ELEMS = 5767168;
constexpr size_t WS_W = 0, WS_MOD = 100663296, WS_ROPE = 101548032, WS_H = 102072320, WS_AR = 148209664, WS_BAR = 372342784, WS_GST = WS_BAR + 16384, WS_END = WS_GST + 81920;
constexpr size_t A_CQ = 0, A_KVIN = 31457280, A_KR = 42991616, A_DN = 45875200, A_QH = 45875200, A_KH = A_QH + 62914560, A_VT = A_KH + 69206016;
constexpr size_t D_QH = 0, D_KH = 41943040, D_VT = 88080384, D_O2 = 134217728;
constexpr size_t F_ACT = 0, F_HALO = 115343360;
constexpr size_t O_CKV = 20971520, O_KR = 22020096, O_DK = 22282240, O_DV = 26476544;

struct Params { const float* in[44]; float* out; unsigned char* ws; };
typedef const __attribute__((address_space(4))) Params* KP;

__device__ __forceinline__ int tidx() { int t = (int)threadIdx.x; asm volatile("" : "+v"(t)); return t; }
__device__ __forceinline__ int bidx() { int b = (int)blockIdx.x; asm volatile("" : "+s"(b)); return b; }
__device__ __forceinline__ unsigned cvt_pk_bf16(float lo, float hi) { unsigned r; asm volatile("v_cvt_pk_bf16_f32 %0, %1, %2" : "=v"(r) : "v"(lo), "v"(hi)); return r; }
__device__ __forceinline__ bf16_t f2bf(float x) { return (bf16_t)(cvt_pk_bf16(x, 0.f) & 0xffffu); }
__device__ __forceinline__ float bf2f(unsigned b) { return __uint_as_float(b << 16); }
__device__ __forceinline__ float bflo(unsigned w) { return __uint_as_float(w << 16); }
__device__ __forceinline__ float bfhi(unsigned w) { return __uint_as_float(w & 0xffff0000u); }
__device__ __forceinline__ float wave_sum(float v) {
#pragma unroll
    for (int o = 32; o >= 1; o >>= 1) v += __shfl_xor(v, o);
    return v;
}
__device__ __forceinline__ float silu_f(float x) { return x * __builtin_amdgcn_rcpf(1.0f + __builtin_amdgcn_exp2f(-x * LOG2E)); }
__device__ __forceinline__ float gelu_tanh_f(float x) {
    const float z = 0.7978845608028654f * (x + 0.044715f * x * x * x);
    const float e = __builtin_amdgcn_exp2f(2.0f * LOG2E * z);
    const float th = 1.0f - 2.0f * __builtin_amdgcn_rcpf(e + 1.0f);
    return 0.5f * x * (1.0f + th);
}
__device__ __forceinline__ const float* xrow(const float* xp, const float* xs, int row) { return row < TP ? xp + (size_t)row * D : xs + (size_t)(row - TP) * D; }
__device__ __forceinline__ int kvrow_of(int row) { if (row < TP) return row; const int r = row - TP; return TP + (r >> 11) * LLAT + 256 + (r & 2047); }

namespace pg8 {
constexpr int BM = 256, BK = 64, HALF = 128, HTB = HALF * BK * 2, NXCD = 8, WGM = 8;
__device__ __forceinline__ int lds_byte(int r, int c) { const int st = (r >> 4) * 2 + (c >> 5), rr = r & 15, cc = c & 31, ob = rr * 64 + cc * 2; return st * 1024 + (ob ^ (((ob >> 9) & 1) << 5)); }
__device__ __forceinline__ void stage_rc(int b, int& R, int& C) { const int st = b / 1024, sb = b % 1024, swz = sb ^ (((sb >> 9) & 1) << 5); R = (st >> 1) * 16 + swz / 64; C = (st & 1) * 32 + (swz % 64) / 2; }
__device__ __forceinline__ int perm32(int rho) { const int n = rho >> 4, i = rho & 15; return 8 * (i >> 2) + 4 * n + (i & 3); }
struct Unit { int pm, pn; };
struct Gemm { const bf16_t* A; const bf16_t* Bt; int M, N, K; };
struct StaticOrder {
    int nM, nN, nwg, G, c;
    __device__ void init(int M, int N, int G_, int c_) { nM = M / BM; nN = N / BM; nwg = nM * nN; G = G_; c = c_; }
    __device__ bool next(int i, Unit& u) const {
        const long L = (long)i * G + c; if (L >= nwg) return false;
        int wgid = (int)L; { const int q = nwg / NXCD, r = nwg % NXCD, xcd = wgid % NXCD, off = wgid / NXCD; wgid = (xcd < r ? xcd * (q + 1) : r * (q + 1) + (xcd - r) * q) + off; }
        const int nig = WGM * nN, gid = wgid / nig, fm = gid * WGM, gsz = (nM - fm) < WGM ? (nM - fm) : WGM;
        u.pm = fm + ((wgid % nig) % gsz); u.pn = (wgid % nig) / gsz; return true;
    }
};

struct PanelOrder {
    int c, round;
    __device__ __forceinline__ bool next(int i, Unit& u) const {
        if (i > 0) return false;
        const int xcd = c & 7, idx = c >> 3;
        if (round == 0) { u.pm = xcd * 8 + (idx >> 2); u.pn = idx & 3; return true; }
        if (c >= 64) return false;
        u.pm = 64 + xcd * 2 + (idx >> 2); u.pn = idx & 3; return true;
    }
};
template <class Epi, class Sched>
__device__ __forceinline__ void gemm_phase(LAS unsigned char* lds, const Gemm g, const Sched& S, const Epi& E) {
    const int tid = tidx(), wid = __builtin_amdgcn_readfirstlane(tid >> 6), lane = tid & 63, wr = wid >> 2, wc = wid & 3, fr = lane & 15, fq = lane >> 4;
    int K = g.K; asm volatile("" : "+s"(K)); const int nt = K / BK;
    unsigned voffA[2], voffB[2];
#pragma unroll
    for (int i = 0; i < 2; ++i) { int R, C; stage_rc(tid * 16 + i * 8192, R, C); const int Rb = Epi::PERM ? ((R & ~31) + perm32(R & 31)) : R;
        const int Ra = Epi::APERM ? (128 * (R >> 6) + 8 * (R & 15) + ((R >> 4) & 3)) : R;
        voffA[i] = (unsigned)(Ra * K + C) * 2u; voffB[i] = (unsigned)(Rb * K + C) * 2u; }
    const size_t kstep = (size_t)(BK * 2);
    const size_t hstepB = (size_t)HALF * K * 2;
    const size_t hstepA = Epi::APERM ? (size_t)4 * K * 2 : hstepB;
    const size_t tstep = 2 * hstepB;
    const unsigned ldsw = (unsigned)wid * 1024u;
    const int aoff = lds_byte(wr * 64 + fr, fq * 8), boff = lds_byte(wc * 32 + fr, fq * 8);
#define PG8_SA(b, h) (((b) * 2 + (h)) * HTB)
#define PG8_SB(b, h) ((4 + (b) * 2 + (h)) * HTB)
#define PG8_STAGE(bufoff, gbase, voff) do { _Pragma("unroll") for (int _i = 0; _i < 2; ++_i) \
        __builtin_amdgcn_global_load_lds((const unsigned*)((const char*)(gbase) + (voff)[_i]), (LAS unsigned*)(lds + (bufoff) + ldsw + _i * 8192), 16, 0, 0); } while (0)
#define PG8_LDA(dst, b, h) do { _Pragma("unroll") for (int m = 0; m < 4; ++m) _Pragma("unroll") for (int k = 0; k < 2; ++k) dst[m][k] = *(const LAS bf16x8*)(lds + PG8_SA(b, h) + aoff + m * 2048 + k * 1024); } while (0)
#define PG8_LDB(dst, b, h) do { _Pragma("unroll") for (int n = 0; n < 2; ++n) _Pragma("unroll") for (int k = 0; k < 2; ++k) dst[n][k] = *(const LAS bf16x8*)(lds + PG8_SB(b, h) + boff + n * 2048 + k * 1024); } while (0)
#define PG8_MMA(ai, bj, At, Bt) do { __builtin_amdgcn_s_setprio(1); _Pragma("unroll") for (int m = 0; m < 4; ++m) _Pragma("unroll") for (int n = 0; n < 2; ++n) _Pragma("unroll") for (int k = 0; k < 2; ++k) \
        acc[ai][bj][m][n] = __builtin_amdgcn_mfma_f32_16x16x32_bf16(Bt[n][k], At[m][k], acc[ai][bj][m][n], 0, 0, 0); __builtin_amdgcn_s_setprio(0); } while (0)
#define PG8_WAIT_V(n) asm volatile("s_waitcnt vmcnt(" #n ")" ::: "memory")
#define PG8_WAIT_L(n) asm volatile("s_waitcnt lgkmcnt(" #n ")" ::: "memory")
#define PG8_BAR __builtin_amdgcn_s_barrier()
#define PG8_SCHED __builtin_amdgcn_sched_barrier(0)
    Unit cur, nxt; int ui = 0;
    if (!S.next(0, cur)) return;
    f32x4 acc[2][2][4][2];
#pragma unroll
    for (int a = 0; a < 2; ++a)
#pragma unroll
        for (int b = 0; b < 2; ++b)
#pragma unroll
            for (int m = 0; m < 4; ++m)
#pragma unroll
                for (int n = 0; n < 2; ++n) acc[a][b][m][n] = (f32x4){0.f, 0.f, 0.f, 0.f};
    bf16x8 At[4][2], B0[2][2], B1[2][2];
    const char* cA = (const char*)g.A + (size_t)cur.pm * tstep; const char* cB = (const char*)g.Bt + (size_t)cur.pn * tstep;
    PG8_STAGE(PG8_SB(0, 0), cB, voffB); PG8_STAGE(PG8_SA(0, 0), cA, voffA); PG8_STAGE(PG8_SB(0, 1), cB + hstepB, voffB); PG8_STAGE(PG8_SA(0, 1), cA + hstepA, voffA);
    if (wr == 1) PG8_BAR;
    PG8_WAIT_V(4); PG8_BAR;
    PG8_STAGE(PG8_SB(1, 0), cB + kstep, voffB); PG8_STAGE(PG8_SA(1, 0), cA + kstep, voffA); PG8_STAGE(PG8_SB(1, 1), cB + hstepB + kstep, voffB);
    PG8_WAIT_V(6); PG8_BAR;
    for (;;) {
        const bool has_next = S.next(ui + 1, nxt);
        const char* nA = has_next ? (const char*)g.A + (size_t)nxt.pm * tstep : cA; const char* nB = has_next ? (const char*)g.Bt + (size_t)nxt.pn * tstep : cB;
        for (int t = 0; t < nt; t += 2) {
            const bool last = (t == nt - 2);
            const char* a1 = cA + (size_t)(t + 1) * kstep;
            const char* a2 = last ? nA : cA + (size_t)(t + 2) * kstep; const char* b2 = last ? nB : cB + (size_t)(t + 2) * kstep;
            const char* a3 = a2 + kstep; const char* b3 = b2 + kstep;
            PG8_LDB(B0, 0, 0); PG8_SCHED; PG8_LDA(At, 0, 0); PG8_STAGE(PG8_SA(1, 1), a1 + hstepA, voffA);
            PG8_WAIT_L(8); PG8_BAR; PG8_WAIT_L(0); PG8_MMA(0, 0, At, B0); PG8_BAR; PG8_SCHED;
            PG8_LDB(B1, 0, 1); PG8_STAGE(PG8_SB(0, 0), b2, voffB);
            PG8_BAR; PG8_WAIT_L(0); PG8_MMA(0, 1, At, B1); PG8_BAR;
            PG8_LDA(At, 0, 1); PG8_STAGE(PG8_SA(0, 0), a2, voffA);
            PG8_BAR; PG8_WAIT_L(0); PG8_MMA(1, 0, At, B0); PG8_BAR; PG8_SCHED;
            PG8_STAGE(PG8_SB(0, 1), b2 + hstepB, voffB);
            PG8_WAIT_V(6); PG8_BAR; PG8_MMA(1, 1, At, B1); PG8_BAR;
            PG8_LDB(B0, 1, 0); PG8_SCHED; PG8_LDA(At, 1, 0); PG8_STAGE(PG8_SA(0, 1), a2 + hstepA, voffA);
            PG8_WAIT_L(8); PG8_BAR; PG8_WAIT_L(0); PG8_MMA(0, 0, At, B0); PG8_BAR; PG8_SCHED;
            PG8_LDB(B1, 1, 1); PG8_STAGE(PG8_SB(1, 0), b3, voffB);
            PG8_BAR; PG8_WAIT_L(0); PG8_MMA(0, 1, At, B1); PG8_BAR;
            PG8_LDA(At, 1, 1); PG8_STAGE(PG8_SA(1, 0), a3, voffA);
            PG8_BAR; PG8_WAIT_L(0); PG8_MMA(1, 0, At, B0); PG8_BAR; PG8_SCHED;
            PG8_STAGE(PG8_SB(1, 1), b3 + hstepB, voffB);
            PG8_WAIT_V(6); PG8_BAR; PG8_MMA(1, 1, At, B1); PG8_BAR;
        }
        E(acc, cur, wr, wc, fr, fq);
        if (!has_next) break;
#pragma unroll
        for (int a = 0; a < 2; ++a)
#pragma unroll
            for (int b = 0; b < 2; ++b)
#pragma unroll
                for (int m = 0; m < 4; ++m)
#pragma unroll
                    for (int n = 0; n < 2; ++n) acc[a][b][m][n] = (f32x4){0.f, 0.f, 0.f, 0.f};
        cur = nxt; cA = nA; cB = nB; ++ui;
    }
    PG8_WAIT_V(0);
    if (wr == 0) PG8_BAR;
    PG8_BAR;
#undef PG8_SA
#undef PG8_SB
#undef PG8_STAGE
#undef PG8_LDA
#undef PG8_LDB
#undef PG8_MMA
#undef PG8_WAIT_V
#undef PG8_WAIT_L
#undef PG8_BAR
#undef PG8_SCHED
}
}
using pg8::Unit;
typedef f32x4 Acc[2][2][4][2];

struct EpiF32Plain {
    static constexpr bool PERM = false, APERM = false;
    float* C; int ldc;
    __device__ __forceinline__ void operator()(Acc& acc, const Unit& u, int wr, int wc, int fr, int fq) const {
        asm volatile("" : "+v"(fr), "+v"(fq));
        const int row0 = u.pm * 256 + wr * 64 + fr, col0 = u.pn * 256 + wc * 32 + 4 * fq;
#pragma unroll
        for (int ai = 0; ai < 2; ++ai)
#pragma unroll
            for (int m = 0; m < 4; ++m) { float* rowp = C + (size_t)(row0 + ai * 128 + m * 16) * ldc + col0;
#pragma unroll
                for (int bj = 0; bj < 2; ++bj)
#pragma unroll
                    for (int n = 0; n < 2; ++n) *(f32x4*)(rowp + bj * 128 + n * 16) = acc[ai][bj][m][n]; }
    }
};
struct EpiResid {
    static constexpr bool PERM = false, APERM = false;
    const float* xp; const float* xs; float* Y; float* Yo; const float* gate; int first;
    __device__ __forceinline__ void operator()(Acc& acc, const Unit& u, int wr, int wc, int fr, int fq) const {
        asm volatile("" : "+v"(fr), "+v"(fq));
        const int cr = u.pm < 16 ? 0 : 1 + ((u.pm - 16) >> 3);
        const float* g = gate + cr * 6144;
        const int row0 = u.pm * 256 + wr * 64 + fr, col0 = u.pn * 256 + wc * 32 + 4 * fq;
        f32x4 gv[2][2];
#pragma unroll
        for (int bj = 0; bj < 2; ++bj)
#pragma unroll
            for (int n = 0; n < 2; ++n) gv[bj][n] = *(const f32x4*)(g + col0 + bj * 128 + n * 16);
#pragma unroll
        for (int ai = 0; ai < 2; ++ai)
#pragma unroll
            for (int m = 0; m < 4; ++m) { const int row = row0 + ai * 128 + m * 16;
                const float* b = first ? xrow(xp, xs, row) : Y + (size_t)row * D; float* o = Yo + (size_t)row * D;
#pragma unroll
                for (int bj = 0; bj < 2; ++bj)
#pragma unroll
                    for (int n = 0; n < 2; ++n) { const int c = col0 + bj * 128 + n * 16; *(f32x4*)(o + c) = *(const f32x4*)(b + c) + gv[bj][n] * acc[ai][bj][m][n]; } }
    }
};
template <int ACT> struct EpiBf16 {
    static constexpr bool PERM = true, APERM = false;
    bf16_t* O; int ldc; float* vst; int vpn0;
    __device__ __forceinline__ void operator()(Acc& acc, const Unit& u, int wr, int wc, int fr, int fq) const {
        asm volatile("" : "+v"(fr), "+v"(fq));
        const int row0 = u.pm * 256 + wr * 64 + fr, col0 = u.pn * 256 + wc * 32 + 8 * fq;
        const bool dost = vst != nullptr && u.pn >= vpn0;
#pragma unroll
        for (int ai = 0; ai < 2; ++ai)
#pragma unroll
            for (int m = 0; m < 4; ++m) { const int row = row0 + ai * 128 + m * 16; bf16_t* rowp = O + (size_t)row * ldc + col0; float ss = 0.f;
#pragma unroll
                for (int bj = 0; bj < 2; ++bj) { f32x4 v0 = acc[ai][bj][m][0], v1 = acc[ai][bj][m][1];
                    if (ACT == 1) {
#pragma unroll
                        for (int j = 0; j < 4; ++j) { v0[j] = gelu_tanh_f(v0[j]); v1[j] = gelu_tanh_f(v1[j]); } }
                    ss += (v0[0] * v0[0] + v0[1] * v0[1]) + (v0[2] * v0[2] + v0[3] * v0[3]) + (v1[0] * v1[0] + v1[1] * v1[1]) + (v1[2] * v1[2] + v1[3] * v1[3]);
                    u32x4 w; w.x = cvt_pk_bf16(v0[0], v0[1]); w.y = cvt_pk_bf16(v0[2], v0[3]); w.z = cvt_pk_bf16(v1[0], v1[1]); w.w = cvt_pk_bf16(v1[2], v1[3]);
                    *(u32x4*)(rowp + bj * 128) = w; }
                if (dost) { ss += __shfl_xor(ss, 16); ss += __shfl_xor(ss, 32); if (fq == 0) (void)__hip_atomic_fetch_add(vst + row, ss, __ATOMIC_RELAXED, __HIP_MEMORY_SCOPE_AGENT); } }
    }
};
struct EpiKV {
    static constexpr bool PERM = true, APERM = false;
    bf16_t* Kh; bf16_t* Vr;
    __device__ __forceinline__ void operator()(Acc& acc, const Unit& u, int wr, int wc, int fr, int fq) const {
        asm volatile("" : "+v"(fr), "+v"(fq));
        const int row0 = u.pm * 256 + wr * 64 + fr;
        bf16_t* dst; int ld, bjs;
        if (u.pn < 4) { dst = Kh + 2 * u.pn * 192 + wc * 32 + 8 * fq; ld = 1536; bjs = 192; }
        else { dst = Vr + (u.pn - 4) * 256 + wc * 32 + 8 * fq; ld = 1024; bjs = 128; }
#pragma unroll
        for (int ai = 0; ai < 2; ++ai)
#pragma unroll
            for (int m = 0; m < 4; ++m) { bf16_t* rowp = dst + (size_t)(row0 + ai * 128 + m * 16) * ld;
#pragma unroll
                for (int bj = 0; bj < 2; ++bj) { const f32x4 v0 = acc[ai][bj][m][0], v1 = acc[ai][bj][m][1];
                    u32x4 w; w.x = cvt_pk_bf16(v0[0], v0[1]); w.y = cvt_pk_bf16(v0[2], v0[3]); w.z = cvt_pk_bf16(v1[0], v1[1]); w.w = cvt_pk_bf16(v1[2], v1[3]);
                    *(u32x4*)(rowp + bj * bjs) = w; } }
    }
};
struct EpiQKV {
    static constexpr bool PERM = true, APERM = false;
    bf16_t* Qh; bf16_t* Kh; bf16_t* Vr; float* sdv;
    __device__ __forceinline__ void operator()(Acc& acc, const Unit& u, int wr, int wc, int fr, int fq) const {
        asm volatile("" : "+v"(fr), "+v"(fq));
        const int rl0 = wr * 64 + fr;
        int kvrow0;
        if (u.pm < 16) kvrow0 = u.pm * 256; else { const int r = u.pm - 16; kvrow0 = TP + (r >> 3) * LLAT + 256 + (r & 7) * 256; }
        const int sec = u.pn >> 2, cb = (u.pn & 3) * 256 + wc * 32 + 8 * fq;
        bf16_t* dst = sec == 0 ? Qh + (size_t)(u.pm * 256) * 1024 : (sec == 1 ? Kh : Vr) + (size_t)kvrow0 * 1024;
        dst += cb;
#pragma unroll
        for (int ai = 0; ai < 2; ++ai)
#pragma unroll
            for (int m = 0; m < 4; ++m) { const int rl = rl0 + ai * 128 + m * 16; bf16_t* rowp = dst + (size_t)rl * 1024;
#pragma unroll
                for (int bj = 0; bj < 2; ++bj) { const f32x4 v0 = acc[ai][bj][m][0], v1 = acc[ai][bj][m][1];
                    u32x4 w; w.x = cvt_pk_bf16(v0[0], v0[1]); w.y = cvt_pk_bf16(v0[2], v0[3]); w.z = cvt_pk_bf16(v1[0], v1[1]); w.w = cvt_pk_bf16(v1[2], v1[3]);
                    *(u32x4*)(rowp + bj * 128) = w;
                    if (sec == 2 && u.pm < 16) { float* sp = sdv + (size_t)(u.pm * 256 + rl) * 1024 + cb + bj * 128; *(f32x4*)sp = v0; *(f32x4*)(sp + 4) = v1; } } }
    }
};
struct EpiFFN {
    static constexpr bool PERM = true, APERM = true;
    bf16_t* ACT; float* HALO; const float* cw; const float* cb;
    __device__ __forceinline__ void operator()(Acc& acc, const Unit& u, int wr, int wc, int fr, int fq) const {
        asm volatile("" : "+v"(fr), "+v"(fq));
        const int tbase = u.pm * 256 + wr * 128 + fr * 8;
        const int run = u.pm * 2 + wr;
#pragma unroll
        for (int n = 0; n < 2; ++n) {
            const int ch = u.pn * 128 + wc * 32 + 8 * fq + 4 * n;
            f32x4 Gm, Gp, Um, Up;
#pragma unroll
            for (int i = 0; i < 4; ++i) { Gm[i] = __shfl_up(acc[1][0][3][n][i], 1); Gp[i] = __shfl_down(acc[0][0][0][n][i], 1);
                                          Um[i] = __shfl_up(acc[1][1][3][n][i], 1); Up[i] = __shfl_down(acc[0][1][0][n][i], 1); }
            if (fr == 0) { float* h = HALO + (size_t)(run * 4) * 5632;
                *(f32x4*)(h + ch) = acc[0][0][0][n]; *(f32x4*)(h + 2816 + ch) = acc[0][1][0][n];
                *(f32x4*)(h + 5632 + ch) = acc[0][0][1][n]; *(f32x4*)(h + 5632 + 2816 + ch) = acc[0][1][1][n]; }
            if (fr == 15) { float* h = HALO + (size_t)(run * 4 + 2) * 5632;
                *(f32x4*)(h + ch) = acc[1][0][2][n]; *(f32x4*)(h + 2816 + ch) = acc[1][1][2][n];
                *(f32x4*)(h + 5632 + ch) = acc[1][0][3][n]; *(f32x4*)(h + 5632 + 2816 + ch) = acc[1][1][3][n]; }
            {
                const f32x4 w0 = *(const f32x4*)(cw + ch), w1 = *(const f32x4*)(cw + 5632 + ch), w2 = *(const f32x4*)(cw + 11264 + ch), bb = *(const f32x4*)(cb + ch);
                f32x4 prev = Gm;
#pragma unroll
                for (int j = 0; j < 8; ++j) { const f32x4 cur = acc[j >> 2][0][j & 3][n]; const f32x4 nx = j == 7 ? Gp : acc[(j + 1) >> 2][0][(j + 1) & 3][n];
                    const f32x4 cg = w0 * prev + w1 * cur + w2 * nx + bb; f32x4 o;
#pragma unroll
                    for (int i = 0; i < 4; ++i) o[i] = silu_f(cg[i]);
                    acc[j >> 2][0][j & 3][n] = o; prev = cur; }
            }
            {
                const f32x4 w0 = *(const f32x4*)(cw + 2816 + ch), w1 = *(const f32x4*)(cw + 5632 + 2816 + ch), w2 = *(const f32x4*)(cw + 11264 + 2816 + ch), bb = *(const f32x4*)(cb + 2816 + ch);
                f32x4 prev = Um;
#pragma unroll
                for (int j = 0; j < 8; ++j) { const f32x4 cur = acc[j >> 2][1][j & 3][n]; const f32x4 nx = j == 7 ? Up : acc[(j + 1) >> 2][1][(j + 1) & 3][n];
                    const f32x4 o = (w0 * prev + w1 * cur + w2 * nx + bb) * acc[j >> 2][0][j & 3][n]; prev = cur;
                    const bool edge = (j == 0 && fr == 0) || (j == 7 && fr == 15);
                    if (!edge) { u32x2 w; w.x = cvt_pk_bf16(o[0], o[1]); w.y = cvt_pk_bf16(o[2], o[3]); *(u32x2*)(ACT + (size_t)(tbase + j) * 2816 + ch) = w; } }
            }
        }
    }
};

__device__ __forceinline__ void conv_job(LAS unsigned char* lds, const float* src, bf16_t* dst, int K, int N, int rowoff, int mode, int& base, int G, int bi) {
    const int tid = tidx();
    const int tn = N / 64, ntiles = (K / 64) * tn;
    LAS float* tile = (LAS float*)lds;
    int start = (bi - (base % G) + G) % G;
    for (int t = start; t < ntiles; t += G) {
        const int k0 = (t / tn) * 64, n0 = (t % tn) * 64;
        __syncthreads();
#pragma unroll
        for (int i = 0; i < 8; ++i) { const int idx = tid + 512 * i, kk = idx >> 6, nn = idx & 63; tile[kk * 65 + nn] = src[(size_t)(k0 + kk) * N + n0 + nn]; }
        __syncthreads();
        const int nn = tid >> 3, kg = tid & 7; float v[8];
#pragma unroll
        for (int j = 0; j < 8; ++j) v[j] = tile[(kg * 8 + j) * 65 + nn];
        const int n = n0 + nn; int dr;
        if (mode == 0) dr = n + rowoff; else { const int isup = n >= 2816, n2 = isup ? n - 2816 : n; dr = 256 * (n2 >> 7) + (isup ? 128 : 0) + (n2 & 127); }
        u32x4 w; w.x = cvt_pk_bf16(v[0], v[1]); w.y = cvt_pk_bf16(v[2], v[3]); w.z = cvt_pk_bf16(v[4], v[5]); w.w = cvt_pk_bf16(v[6], v[7]);
        *(u32x4*)(dst + (size_t)dr * K + k0 + kg * 8) = w;
    }
    base += ntiles;
}

__device__ void conv_next(KP p, LAS unsigned char* lds, int nl, int ffn, int nb, int bi) {
    bf16_t* W = (bf16_t*)(p->ws + WS_W);
    int base = 0;
    __syncthreads();
    if (ffn) {
        conv_job(lds, p->in[40] + (size_t)nl * 1024 * 5632, W + OW_FFN + nl * FFN_STRIDE, 1024, 5632, 0, 1, base, nb, bi);
        conv_job(lds, p->in[43] + (size_t)nl * 2816 * 1024, W + OW_FFN + nl * FFN_STRIDE + FIN_ELEMS, 2816, 1024, 0, 0, base, nb, bi);
    } else if (nl == 1) {
        conv_job(lds, p->in[23], W + OW_QKV, 1024, 3072, 0, 0, base, nb, bi);
        conv_job(lds, p->in[31], W + OW_ODIFF, 1024, 1024, 0, 0, base, nb, bi);
    } else if (nl == 2) {
        conv_job(lds, p->in[32], W + OW_SIN, 1024, 3072, 0, 0, base, nb, bi);
        conv_job(lds, p->in[34], W + OW_SOUT, 1024, 1024, 0, 0, base, nb, bi);
    } else {
        conv_job(lds, p->in[35], W + OW_GIN, 1024, 2048, 0, 0, base, nb, bi);
        conv_job(lds, p->in[39], W + OW_GOUT, 1024, 1024, 0, 0, base, nb, bi);
        for (int i = bi * NTHREADS + tidx(); i < 131072 / 4; i += nb * NTHREADS) { const f32x4 v = *(const f32x4*)(p->in[37] + (size_t)i * 4); u32x2 w; w.x = cvt_pk_bf16(v[0], v[1]); w.y = cvt_pk_bf16(v[2], v[3]); *(u32x2*)(W + OW_GS + (size_t)i * 4) = w; }
    }
}

__device__ void phase0(KP p, LAS unsigned char* lds) {
    bf16_t* W = (bf16_t*)(p->ws + WS_W);
    const int G = gridDim.x, tid = tidx(), gtid = bidx() * NTHREADS + tid, gn = G * NTHREADS;
    int base = 0;
    conv_job(lds, p->in[12], W + OW_DOWN, 1024, 1088, 0, 0, base, G, bidx());
    conv_job(lds, p->in[15], W + OW_UQ, 768, 1536, 0, 0, base, G, bidx());
    conv_job(lds, p->in[16], W + OW_UKV, 256, 1024, 0, 0, base, G, bidx());
    conv_job(lds, p->in[17], W + OW_UKV, 256, 1024, 1024, 0, base, G, bidx());
    conv_job(lds, p->in[22], W + OW_OMLA, 1024, 1024, 0, 0, base, G, bidx());
    conv_job(lds, p->in[40], W + OW_FFN, 1024, 5632, 0, 1, base, G, bidx());
    conv_job(lds, p->in[43], W + OW_FFN + FIN_ELEMS, 2816, 1024, 0, 0, base, G, bidx());
    for (int i = gtid; i < T / 4; i += gn) *(f32x4*)((float*)(p->ws + WS_GST) + 4 * i) = (f32x4){0.f, 0.f, 0.f, 0.f};
    for (int i = gtid; i < 192 * 1024 / 8; i += gn) *(u32x4*)(W + OW_DOWN + (size_t)1088 * 1024 + (size_t)i * 8) = (u32x4){0u, 0u, 0u, 0u};
    { float* RC = (float*)(p->ws + WS_ROPE); float* RS = RC + 65536;
      for (int i = gtid; i < 65536; i += gn) { const int s = i >> 5, f = i & 31, fi = f & 15; const float pos = (float)(f < 16 ? (s >> 6) : (s & 63));
          const float inv = exp2f(-(float)fi * (13.287712379549449f / 16.0f)); const float ang = pos * inv; RC[i] = __cosf(ang); RS[i] = __sinf(ang); } }
    { bf16_t* KVIN = (bf16_t*)(p->ws + WS_AR + A_KVIN); bf16_t* KR = (bf16_t*)(p->ws + WS_AR + A_KR);
      for (int i = gtid; i < 8 * 256 * 256 / 4; i += gn) { const int e = i * 4, c = e & 255, pp = (e >> 8) & 255, b = e >> 16; const f32x4 v = *(const f32x4*)(p->in[2] + e);
          u32x2 w; w.x = cvt_pk_bf16(v[0], v[1]); w.y = cvt_pk_bf16(v[2], v[3]); *(u32x2*)(KVIN + (size_t)(TP + b * LLAT + pp) * 256 + c) = w; }
      for (int i = gtid; i < 8 * 256 * 64 / 4; i += gn) { const int e = i * 4, c = e & 63, pp = (e >> 6) & 255, b = e >> 14; const f32x4 v = *(const f32x4*)(p->in[3] + e);
          u32x2 w; w.x = cvt_pk_bf16(v[0], v[1]); w.y = cvt_pk_bf16(v[2], v[3]); *(u32x2*)(KR + (size_t)(TP + b * LLAT + pp) * 64 + c) = w; } }
    { float* MOD = (float*)(p->ws + WS_MOD); LAS float* sc = (LAS float*)lds;
      const int wid = tid >> 6, lane = tid & 63;
      __syncthreads();
      for (int i = tid; i < 9 * 1024; i += NTHREADS) { const int r = i >> 10, k = i & 1023; const float c = r == 0 ? p->in[7][k] : p->in[6][(r - 1) * 1024 + k]; sc[i] = silu_f(c); }
      __syncthreads();
      LAS float* part = sc + 9 * 1024;
      const int rg = lane >> 4, cg = lane & 15;
      for (int it = bidx(); it < 4 * 96; it += G) {
          const int layer = it / 96, n0 = (it % 96) * 64;
          const float* w = p->in[8] + (size_t)layer * 1024 * 6144 + n0 + cg * 4;
          f32x4 a[9];
#pragma unroll
          for (int r = 0; r < 9; ++r) a[r] = (f32x4){0.f, 0.f, 0.f, 0.f};
          const int kb = wid * 128 + rg;
#pragma unroll 8
          for (int j = 0; j < 32; ++j) { const int k = kb + 4 * j; const f32x4 wv = *(const f32x4*)(w + (size_t)k * 6144);
#pragma unroll
              for (int r = 0; r < 9; ++r) a[r] += wv * sc[r * 1024 + k]; }
#pragma unroll
          for (int r = 0; r < 9; ++r)
#pragma unroll
              for (int i = 0; i < 4; ++i) { float v = a[r][i]; v += __shfl_xor(v, 16); v += __shfl_xor(v, 32); a[r][i] = v; }
          if (rg == 0) {
#pragma unroll
              for (int r = 0; r < 9; ++r)
#pragma unroll
                  for (int i = 0; i < 4; ++i) part[(wid * 9 + r) * 64 + cg * 4 + i] = a[r][i]; }
          __syncthreads();
          for (int o = tid; o < 9 * 64; o += NTHREADS) { const int r = o >> 6, l = o & 63; float s = 0.f;
#pragma unroll
              for (int w8 = 0; w8 < 8; ++w8) s += part[(w8 * 9 + r) * 64 + l];
              const int nn = n0 + l; MOD[(size_t)(layer * 9 + r) * 6144 + nn] = s + p->in[9][layer * 6144 + nn]; }
          __syncthreads();
      } }
}

__device__ void phase_norm(KP p, int layer, int which, int first, int row_lo, int row_hi, int nb, int bi) {
    const int wid = tidx() >> 6, lane = tidx() & 63;
    const float* gp = (which ? p->in[11] : p->in[10]) + layer * 1024;
    const int shift_off = which ? 3072 : 0, scale_off = which ? 4096 : 1024;
    const float* MOD = (const float*)(p->ws + WS_MOD);
    bf16_t* H = (bf16_t*)(p->ws + WS_H);
    for (int row = row_lo + bi * 8 + wid; row < row_hi; row += nb * 8) {
        const float* src = first ? xrow(p->in[0], p->in[1], row) : p->out + (size_t)row * D;
        const int cr = row < TP ? 0 : 1 + ((row - TP) >> 11);
        const float* md = MOD + (size_t)(layer * 9 + cr) * 6144;
        f32x4 v[4]; float ss = 0.f;
#pragma unroll
        for (int i = 0; i < 4; ++i) { v[i] = *(const f32x4*)(src + i * 256 + lane * 4); ss += v[i][0] * v[i][0] + v[i][1] * v[i][1] + v[i][2] * v[i][2] + v[i][3] * v[i][3]; }
        ss = wave_sum(ss); const float rs = rsqrtf(ss * (1.0f / 1024.0f) + EPS);
#pragma unroll
        for (int i = 0; i < 4; ++i) { const int c = i * 256 + lane * 4;
            const f32x4 g = *(const f32x4*)(gp + c), sc = *(const f32x4*)(md + scale_off + c), sh = *(const f32x4*)(md + shift_off + c);
            const f32x4 o = v[i] * rs * g * (sc + 1.0f) + sh;
            u32x2 w; w.x = cvt_pk_bf16(o[0], o[1]); w.y = cvt_pk_bf16(o[2], o[3]); *(u32x2*)(H + (size_t)row * D + c) = w; }
    }
}

__device__ void phase_mla_post_down(KP p) {
    const int wid = tidx() >> 6, lane = tidx() & 63;
    const float* Dn = (const float*)(p->ws + WS_AR + A_DN);
    bf16_t* CQ = (bf16_t*)(p->ws + WS_AR + A_CQ); bf16_t* KVIN = (bf16_t*)(p->ws + WS_AR + A_KVIN); bf16_t* KR = (bf16_t*)(p->ws + WS_AR + A_KR);
    const float* RC = (const float*)(p->ws + WS_ROPE); const float* RS = RC + 65536;
    const float* qn = p->in[13]; const float* kvn = p->in[14]; const float* knr = p->in[21];
    for (int row = bidx() * 8 + wid; row < T; row += gridDim.x * 8) {
        const float* d = Dn + (size_t)row * 1280;
        f32x4 q[3]; float ss = 0.f;
#pragma unroll
        for (int i = 0; i < 3; ++i) { q[i] = *(const f32x4*)(d + i * 256 + lane * 4); ss += q[i][0] * q[i][0] + q[i][1] * q[i][1] + q[i][2] * q[i][2] + q[i][3] * q[i][3]; }
        const f32x4 kv = *(const f32x4*)(d + 768 + lane * 4); float s2 = kv[0] * kv[0] + kv[1] * kv[1] + kv[2] * kv[2] + kv[3] * kv[3];
        const float kr = d[1024 + lane]; float s3 = kr * kr;
#pragma unroll
        for (int o = 32; o >= 1; o >>= 1) { ss += __shfl_xor(ss, o); s2 += __shfl_xor(s2, o); s3 += __shfl_xor(s3, o); }
        const float r1 = rsqrtf(ss * (1.0f / 768.0f) + EPS), r2 = rsqrtf(s2 * (1.0f / 256.0f) + EPS), r3 = rsqrtf(s3 * (1.0f / 64.0f) + EPS);
#pragma unroll
        for (int i = 0; i < 3; ++i) { const int c = i * 256 + lane * 4; const f32x4 o = q[i] * r1 * *(const f32x4*)(qn + c);
            u32x2 w; w.x = cvt_pk_bf16(o[0], o[1]); w.y = cvt_pk_bf16(o[2], o[3]); *(u32x2*)(CQ + (size_t)row * 768 + c) = w; }
        const int kvr = kvrow_of(row);
        { const f32x4 o = kv * r2 * *(const f32x4*)(kvn + lane * 4);
          u32x2 w; w.x = cvt_pk_bf16(o[0], o[1]); w.y = cvt_pk_bf16(o[2], o[3]); *(u32x2*)(KVIN + (size_t)kvr * 256 + lane * 4) = w;
          if (row < TP) *(f32x4*)(p->out + O_CKV + (size_t)row * 256 + lane * 4) = o; }
        { float val = kr * r3 * knr[lane];
          if (row < TP) p->out[O_KR + (size_t)row * 64 + lane] = val;
          else { const int s = (row - TP) & 2047; const float other = __shfl_xor(val, 32); const int f = lane & 31; const float cs = RC[s * 32 + f], sn = RS[s * 32 + f];
                 val = lane < 32 ? val * cs - other * sn : val * cs + other * sn; }
          KR[(size_t)kvr * 64 + lane] = f2bf(val); }
    }
}

__device__ void phase_mla_headprep(KP p) {
    const int wid = tidx() >> 6, lane = tidx() & 63, hq = lane >> 4, l16 = lane & 15;
    bf16_t* Qh = (bf16_t*)(p->ws + WS_AR + A_QH); bf16_t* Kh = (bf16_t*)(p->ws + WS_AR + A_KH); const bf16_t* KR = (const bf16_t*)(p->ws + WS_AR + A_KR);
    const float* RC = (const float*)(p->ws + WS_ROPE); const float* RS = RC + 65536;
    const float qs = 0.07216878364870322f * LOG2E;
    const f32x4 qnn0 = *(const f32x4*)(p->in[18] + 8 * l16), qnn1 = *(const f32x4*)(p->in[18] + 8 * l16 + 4), qnr = *(const f32x4*)(p->in[19] + 4 * l16);
    const f32x4 knn0 = *(const f32x4*)(p->in[20] + 8 * l16), knn1 = *(const f32x4*)(p->in[20] + 8 * l16 + 4);
    const int nw = gridDim.x * 8;
    for (int row = bidx() * 8 + wid; row < T + KVT; row += nw) {
        if (row < T) {
            const bool lat = row >= TP; const int s = (row - TP) & 2047; const int f0 = 4 * (l16 & 7);
            f32x4 cs = (f32x4){1.f, 1.f, 1.f, 1.f}, sn = (f32x4){0.f, 0.f, 0.f, 0.f};
            if (lat) { cs = *(const f32x4*)(RC + s * 32 + f0); sn = *(const f32x4*)(RS + s * 32 + f0); }
            bf16_t* base = Qh + (size_t)row * 1536;
#pragma unroll
            for (int h4 = 0; h4 < 2; ++h4) {
                bf16_t* hb = base + (h4 * 4 + hq) * 192;
                const u32x4 nw4 = *(const u32x4*)(hb + 8 * l16); const u32x2 rw = *(const u32x2*)(hb + 128 + 4 * l16);
                f32x4 a0 = (f32x4){bflo(nw4.x), bfhi(nw4.x), bflo(nw4.y), bfhi(nw4.y)}, a1 = (f32x4){bflo(nw4.z), bfhi(nw4.z), bflo(nw4.w), bfhi(nw4.w)};
                f32x4 r = (f32x4){bflo(rw.x), bfhi(rw.x), bflo(rw.y), bfhi(rw.y)};
                float s1 = a0[0] * a0[0] + a0[1] * a0[1] + a0[2] * a0[2] + a0[3] * a0[3] + a1[0] * a1[0] + a1[1] * a1[1] + a1[2] * a1[2] + a1[3] * a1[3];
                float s2 = r[0] * r[0] + r[1] * r[1] + r[2] * r[2] + r[3] * r[3];
#pragma unroll
                for (int o = 1; o <= 8; o <<= 1) { s1 += __shfl_xor(s1, o); s2 += __shfl_xor(s2, o); }
                const float rn = rsqrtf(s1 * (1.0f / 128.0f) + EPS) * qs, rr = rsqrtf(s2 * (1.0f / 64.0f) + EPS);
                a0 = a0 * rn * qnn0; a1 = a1 * rn * qnn1; r = r * rr * qnr;
                if (lat) { f32x4 ot;
#pragma unroll
                    for (int j = 0; j < 4; ++j) ot[j] = __shfl_xor(r[j], 8);
                    r = l16 < 8 ? r * cs - ot * sn : r * cs + ot * sn; }
                r = r * qs;
                u32x4 ow; ow.x = cvt_pk_bf16(a0[0], a0[1]); ow.y = cvt_pk_bf16(a0[2], a0[3]); ow.z = cvt_pk_bf16(a1[0], a1[1]); ow.w = cvt_pk_bf16(a1[2], a1[3]);
                u32x2 orr; orr.x = cvt_pk_bf16(r[0], r[1]); orr.y = cvt_pk_bf16(r[2], r[3]);
                *(u32x4*)(hb + 8 * l16) = ow; *(u32x2*)(hb + 128 + 4 * l16) = orr;
            }
        } else {
            const int kr = row - T; bf16_t* base = Kh + (size_t)kr * 1536; const u32x2 krv = *(const u32x2*)(KR + (size_t)kr * 64 + 4 * l16);
#pragma unroll
            for (int h4 = 0; h4 < 2; ++h4) {
                bf16_t* hb = base + (h4 * 4 + hq) * 192;
                const u32x4 nw4 = *(const u32x4*)(hb + 8 * l16);
                f32x4 a0 = (f32x4){bflo(nw4.x), bfhi(nw4.x), bflo(nw4.y), bfhi(nw4.y)}, a1 = (f32x4){bflo(nw4.z), bfhi(nw4.z), bflo(nw4.w), bfhi(nw4.w)};
                float s1 = a0[0] * a0[0] + a0[1] * a0[1] + a0[2] * a0[2] + a0[3] * a0[3] + a1[0] * a1[0] + a1[1] * a1[1] + a1[2] * a1[2] + a1[3] * a1[3];
#pragma unroll
                for (int o = 1; o <= 8; o <<= 1) s1 += __shfl_xor(s1, o);
                const float rn = rsqrtf(s1 * (1.0f / 128.0f) + EPS);
                a0 = a0 * rn * knn0; a1 = a1 * rn * knn1;
                u32x4 ow; ow.x = cvt_pk_bf16(a0[0], a0[1]); ow.y = cvt_pk_bf16(a0[2], a0[3]); ow.z = cvt_pk_bf16(a1[0], a1[1]); ow.w = cvt_pk_bf16(a1[2], a1[3]);
                *(u32x4*)(hb + 8 * l16) = ow; *(u32x2*)(hb + 128 + 4 * l16) = krv;
            }
        }
    }
}

__device__ void phase_diff_cache(KP p) {
    const int gtid = bidx() * NTHREADS + tidx(), gn = gridDim.x * NTHREADS;
    bf16_t* Kh = (bf16_t*)(p->ws + WS_AR + D_KH); bf16_t* Vr = (bf16_t*)(p->ws + WS_AR + D_O2);
    for (int i = gtid; i < 8 * 256 * 1024 / 4; i += gn) { const int e = i * 4, c = e & 1023, pp = (e >> 10) & 255, b = e >> 18;
        const f32x4 v = *(const f32x4*)(p->in[4] + e); const f32x4 v2 = *(const f32x4*)(p->in[5] + e);
        u32x2 w; w.x = cvt_pk_bf16(v[0], v[1]); w.y = cvt_pk_bf16(v[2], v[3]); *(u32x2*)(Kh + (size_t)(TP + b * LLAT + pp) * 1024 + c) = w;
        u32x2 w2; w2.x = cvt_pk_bf16(v2[0], v2[1]); w2.y = cvt_pk_bf16(v2[2], v2[3]); *(u32x2*)(Vr + (size_t)(TP + b * LLAT + pp) * 1024 + c) = w2; }
}

__device__ void phase_vtrans(LAS unsigned char* lds, const bf16_t* Vr, bf16_t* VT) {
    const int tid = tidx();
    for (int t = bidx(); t < 352 * 16; t += gridDim.x) {
        const int kt = t >> 4, ec = t & 15, kvrow0 = kt * 64;
        size_t base; int L, key0;
        if (kvrow0 < TP) { const int sq = kvrow0 >> 8; key0 = kvrow0 & 255; L = 256; base = (size_t)sq * (1024 * 256); }
        else { const int r = kvrow0 - TP, sq = r / LLAT; key0 = r - sq * LLAT; L = LLAT; base = (size_t)TP * 1024 + (size_t)sq * (1024 * LLAT); }
        __syncthreads();
        { const int key = tid >> 3, pc = tid & 7; const u32x4 v = *(const u32x4*)(Vr + (size_t)(kvrow0 + key) * 1024 + ec * 64 + pc * 8);
#pragma unroll
          for (int j = 0; j < 4; ++j) { *(LAS bf16_t*)(lds + (pc * 8 + 2 * j) * 144 + key * 2) = (bf16_t)(v[j] & 0xffffu); *(LAS bf16_t*)(lds + (pc * 8 + 2 * j + 1) * 144 + key * 2) = (bf16_t)(v[j] >> 16); } }
        __syncthreads();
        { const int e = tid >> 3, kp = tid & 7, kg = kp >> 2, g4 = kp & 3;
          const u32x2 lo = *(const LAS u32x2*)(lds + e * 144 + (32 * kg + 4 * g4) * 2), hi = *(const LAS u32x2*)(lds + e * 144 + (32 * kg + 16 + 4 * g4) * 2);
          u32x4 w; w.x = lo.x; w.y = lo.y; w.z = hi.x; w.w = hi.y;
          *(u32x4*)(VT + base + (size_t)(ec * 64 + e) * L + key0 + kp * 8) = w; }
    }
}

__device__ void phase_diff_headprep(KP p) {
    const int wid = tidx() >> 6, lane = tidx() & 63, hq = lane >> 4, l16 = lane & 15, d0 = 4 * l16;
    bf16_t* Qh = (bf16_t*)(p->ws + WS_AR + D_QH); bf16_t* Kh = (bf16_t*)(p->ws + WS_AR + D_KH);
    const float* RC = (const float*)(p->ws + WS_ROPE); const float* RS = RC + 65536;
    const float qs = 0.125f * LOG2E; const f32x4 qn = *(const f32x4*)(p->in[24] + d0), kn = *(const f32x4*)(p->in[25] + d0);
    const int nw = gridDim.x * 8;
    for (int it = bidx() * 8 + wid; it < 2 * T; it += nw) {
        const int row = it >> 1, isk = it & 1;
        const bool lat = row >= TP; const int s = (row - TP) & 2047; const int f0 = 4 * (l16 & 7);
        f32x4 cs = (f32x4){1.f, 1.f, 1.f, 1.f}, sn = (f32x4){0.f, 0.f, 0.f, 0.f};
        if (lat) { cs = *(const f32x4*)(RC + s * 32 + f0); sn = *(const f32x4*)(RS + s * 32 + f0); }
        bf16_t* base = isk ? Kh + (size_t)kvrow_of(row) * 1024 : Qh + (size_t)row * 1024;
        const f32x4 gsc = isk ? kn : qn;
#pragma unroll
        for (int h4 = 0; h4 < 4; ++h4) {
            const int hh = h4 * 4 + hq;
            const u32x2 w = *(const u32x2*)(base + hh * 64 + d0);
            f32x4 v = (f32x4){bflo(w.x), bfhi(w.x), bflo(w.y), bfhi(w.y)};
            float ss = v[0] * v[0] + v[1] * v[1] + v[2] * v[2] + v[3] * v[3];
            ss += __shfl_xor(ss, 1); ss += __shfl_xor(ss, 2); ss += __shfl_xor(ss, 4); ss += __shfl_xor(ss, 8);
            const float rs = rsqrtf(ss * (1.0f / 64.0f) + EPS);
            v = v * rs * gsc;
            if (isk && !lat) *(f32x4*)(p->out + O_DK + (size_t)row * 1024 + hh * 64 + d0) = v;
            if (lat) { f32x4 ot;
#pragma unroll
                for (int j = 0; j < 4; ++j) ot[j] = __shfl_xor(v[j], 8);
                v = l16 < 8 ? v * cs - ot * sn : v * cs + ot * sn; }
            if (!isk) v = v * qs;
            u32x2 o; o.x = cvt_pk_bf16(v[0], v[1]); o.y = cvt_pk_bf16(v[2], v[3]);
            *(u32x2*)(base + hh * 64 + d0) = o;
        }
    }
}

__device__ void phase_diff_combine(KP p) {
    const int wid = tidx() >> 6, lane = tidx() & 63, hq = lane >> 4, l16 = lane & 15;
    const bf16_t* O2 = (const bf16_t*)(p->ws + WS_AR + D_O2); bf16_t* H = (bf16_t*)(p->ws + WS_H);
    const float lam_init = 0.8f - 0.6f * expf(-0.3f);
    const float d1 = wave_sum(p->in[26][lane] * p->in[27][lane]), d2 = wave_sum(p->in[28][lane] * p->in[29][lane]);
    const float lam = expf(d1) - expf(d2) + lam_init;
    const f32x4 hn0 = *(const f32x4*)(p->in[30] + 8 * l16) * (1.0f - lam_init), hn1 = *(const f32x4*)(p->in[30] + 8 * l16 + 4) * (1.0f - lam_init);
    for (int row = bidx() * 8 + wid; row < T; row += gridDim.x * 8) {
        const bf16_t* b = O2 + (size_t)row * 2048;
#pragma unroll
        for (int h4 = 0; h4 < 2; ++h4) {
            const int h = h4 * 4 + hq;
            const u32x4 w0 = *(const u32x4*)(b + h * 128 + 8 * l16), w1 = *(const u32x4*)(b + 1024 + h * 128 + 8 * l16);
            f32x4 a0 = (f32x4){bflo(w0.x) - lam * bflo(w1.x), bfhi(w0.x) - lam * bfhi(w1.x), bflo(w0.y) - lam * bflo(w1.y), bfhi(w0.y) - lam * bfhi(w1.y)};
            f32x4 a1 = (f32x4){bflo(w0.z) - lam * bflo(w1.z), bfhi(w0.z) - lam * bfhi(w1.z), bflo(w0.w) - lam * bflo(w1.w), bfhi(w0.w) - lam * bfhi(w1.w)};
            float ss = a0[0] * a0[0] + a0[1] * a0[1] + a0[2] * a0[2] + a0[3] * a0[3] + a1[0] * a1[0] + a1[1] * a1[1] + a1[2] * a1[2] + a1[3] * a1[3];
            ss += __shfl_xor(ss, 1); ss += __shfl_xor(ss, 2); ss += __shfl_xor(ss, 4); ss += __shfl_xor(ss, 8);
            const float rs = rsqrtf(ss * (1.0f / 128.0f) + EPS);
            a0 = a0 * rs * hn0; a1 = a1 * rs * hn1;
            u32x4 o; o.x = cvt_pk_bf16(a0[0], a0[1]); o.y = cvt_pk_bf16(a0[2], a0[3]); o.z = cvt_pk_bf16(a1[0], a1[1]); o.w = cvt_pk_bf16(a1[2], a1[3]);
            *(u32x4*)(H + (size_t)row * D + h * 128 + 8 * l16) = o;
        }
    }
}

__device__ void phase_sconv_ew(KP p) {
    const int gtid = bidx() * NTHREADS + tidx(), gn = gridDim.x * NTHREADS;
    const bf16_t* S3 = (const bf16_t*)(p->ws + WS_AR); bf16_t* H = (bf16_t*)(p->ws + WS_H); const float* cw = p->in[33];
    for (int i = gtid; i < T * 128; i += gn) {
        const int t = i >> 7, c0 = (i & 127) * 8;
        int pos, len; if (t < TP) { pos = t & 255; len = 256; } else { pos = (t - TP) & 2047; len = 2048; }
        const bf16_t* r = S3 + (size_t)t * 3072;
        const u32x4 gb = *(const u32x4*)(r + c0);
        float pm[8], pc[8], pn[8];
        { const u32x4 a = *(const u32x4*)(r + 1024 + c0), b = *(const u32x4*)(r + 2048 + c0);
#pragma unroll
          for (int j = 0; j < 4; ++j) { pc[2 * j] = bflo(a[j]) * bflo(b[j]); pc[2 * j + 1] = bfhi(a[j]) * bfhi(b[j]); } }
        if (pos > 0) { const u32x4 a = *(const u32x4*)(r - 3072 + 1024 + c0), b = *(const u32x4*)(r - 3072 + 2048 + c0);
#pragma unroll
            for (int j = 0; j < 4; ++j) { pm[2 * j] = bflo(a[j]) * bflo(b[j]); pm[2 * j + 1] = bfhi(a[j]) * bfhi(b[j]); } }
        else {
#pragma unroll
            for (int j = 0; j < 8; ++j) pm[j] = 0.f; }
        if (pos < len - 1) { const u32x4 a = *(const u32x4*)(r + 3072 + 1024 + c0), b = *(const u32x4*)(r + 3072 + 2048 + c0);
#pragma unroll
            for (int j = 0; j < 4; ++j) { pn[2 * j] = bflo(a[j]) * bflo(b[j]); pn[2 * j + 1] = bfhi(a[j]) * bfhi(b[j]); } }
        else {
#pragma unroll
            for (int j = 0; j < 8; ++j) pn[j] = 0.f; }
        float o[8];
#pragma unroll
        for (int j = 0; j < 8; ++j) { const float g = (j & 1) ? bfhi(gb[j >> 1]) : bflo(gb[j >> 1]);
            o[j] = g * (cw[c0 + j] * pm[j] + cw[1024 + c0 + j] * pc[j] + cw[2048 + c0 + j] * pn[j]); }
        u32x4 w; w.x = cvt_pk_bf16(o[0], o[1]); w.y = cvt_pk_bf16(o[2], o[3]); w.z = cvt_pk_bf16(o[4], o[5]); w.w = cvt_pk_bf16(o[6], o[7]);
        *(u32x4*)(H + (size_t)t * D + c0) = w;
    }
}

__device__ void phase_gmlp_spatial(KP p, LAS unsigned char* lds) {
    const int tid = tidx(), wid = tid >> 6, lane = tid & 63, gq = lane >> 4, c = lane & 15;
    const bf16_t* UV = (const bf16_t*)(p->ws + WS_AR); bf16_t* H = (bf16_t*)(p->ws + WS_H);
    const bf16_t* WS_ = (const bf16_t*)(p->ws + WS_W) + OW_GS;
    const float* vn = p->in[36]; const float* bs = p->in[38];
    LAS float* rq = (LAS float*)lds;
    LAS unsigned char* vt = lds + 1024;
    for (int unit = bidx(); unit < 160 * 8; unit += gridDim.x) {
        const int ck = unit >> 3, g = unit & 7, t0 = ck * 128;
        __syncthreads();
        if (tid < 128) rq[tid] = rsqrtf(((const float*)(p->ws + WS_GST))[t0 + tid] * (1.0f / 1024.0f) + EPS);
        __syncthreads();
#pragma unroll
        for (int i = 0; i < 4; ++i) { const int idx = tid + 512 * i, q = idx & 127, pc = idx >> 7;
            const u32x4 a = *(const u32x4*)(UV + (size_t)(t0 + q) * 2048 + 1024 + g * 128 + pc * 8); const float r = rq[q];
#pragma unroll
            for (int j = 0; j < 4; ++j) { const int e = pc * 8 + 2 * j;
                *(LAS bf16_t*)(vt + e * 272 + q * 2) = f2bf(bflo(a[j]) * r * vn[g * 128 + e]);
                *(LAS bf16_t*)(vt + (e + 1) * 272 + q * 2) = f2bf(bfhi(a[j]) * r * vn[g * 128 + e + 1]); } }
        __syncthreads();
        f32x4 acc[8];
#pragma unroll
        for (int et = 0; et < 8; ++et) acc[et] = (f32x4){0.f, 0.f, 0.f, 0.f};
        const int pp = wid * 16 + c;
#pragma unroll
        for (int ks = 0; ks < 4; ++ks) {
            const bf16x8 bfr = *(const bf16x8*)(WS_ + (size_t)(g * 128 + pp) * 128 + ks * 32 + gq * 8);
#pragma unroll
            for (int et = 0; et < 8; ++et) { const bf16x8 afr = *(const LAS bf16x8*)(vt + (et * 16 + c) * 272 + (ks * 32 + gq * 8) * 2);
                acc[et] = __builtin_amdgcn_mfma_f32_16x16x32_bf16(afr, bfr, acc[et], 0, 0, 0); }
        }
        const float bias = bs[g * 128 + pp]; const int tok = t0 + pp;
#pragma unroll
        for (int et = 0; et < 8; ++et) { const int e = g * 128 + et * 16 + 4 * gq; const u32x2 uu = *(const u32x2*)(UV + (size_t)tok * 2048 + e);
            u32x2 w; w.x = cvt_pk_bf16(bflo(uu.x) * (acc[et][0] + bias), bfhi(uu.x) * (acc[et][1] + bias)); w.y = cvt_pk_bf16(bflo(uu.y) * (acc[et][2] + bias), bfhi(uu.y) * (acc[et][3] + bias));
            *(u32x2*)(H + (size_t)tok * D + e) = w; }
    }
}

__device__ void ffn_fix_panel(KP p, int layer, int pm) {
    const float* __restrict__ HALO = (const float*)(p->ws + WS_AR + F_HALO); bf16_t* __restrict__ ACT = (bf16_t*)(p->ws + WS_AR + F_ACT);
    const float* __restrict__ cw = p->in[41] + (size_t)layer * 3 * 5632; const float* __restrict__ cb = p->in[42] + (size_t)layer * 5632;
#pragma unroll 2
    for (int i = tidx(); i < 4 * 704; i += NTHREADS) {
        const int e = i / 704, ch = (i - e * 704) * 4, eg = 4 * pm + e, run = eg >> 1, lastt = eg & 1;
        const int tok = run * 128 + (lastt ? 127 : 0);
        int pos, len; if (tok < TP) { pos = tok & 255; len = 256; } else { pos = (tok - TP) & 2047; len = 2048; }
        const float* hr = HALO + (size_t)(run * 4) * 5632;
        const f32x4 z = (f32x4){0.f, 0.f, 0.f, 0.f};
        f32x4 gp, gc, gnx, up, uc, unx;
        if (!lastt) { gc = *(const f32x4*)(hr + ch); uc = *(const f32x4*)(hr + 2816 + ch); gnx = *(const f32x4*)(hr + 5632 + ch); unx = *(const f32x4*)(hr + 5632 + 2816 + ch);
            if (pos > 0) { gp = *(const f32x4*)(hr - 5632 + ch); up = *(const f32x4*)(hr - 5632 + 2816 + ch); } else { gp = z; up = z; } }
        else { gp = *(const f32x4*)(hr + 2 * 5632 + ch); up = *(const f32x4*)(hr + 2 * 5632 + 2816 + ch); gc = *(const f32x4*)(hr + 3 * 5632 + ch); uc = *(const f32x4*)(hr + 3 * 5632 + 2816 + ch);
            if (pos < len - 1) { gnx = *(const f32x4*)(hr + 4 * 5632 + ch); unx = *(const f32x4*)(hr + 4 * 5632 + 2816 + ch); } else { gnx = z; unx = z; } }
        const f32x4 cg = *(const f32x4*)(cw + ch) * gp + *(const f32x4*)(cw + 5632 + ch) * gc + *(const f32x4*)(cw + 11264 + ch) * gnx + *(const f32x4*)(cb + ch);
        const f32x4 cu = *(const f32x4*)(cw + 2816 + ch) * up + *(const f32x4*)(cw + 5632 + 2816 + ch) * uc + *(const f32x4*)(cw + 11264 + 2816 + ch) * unx + *(const f32x4*)(cb + 2816 + ch);
        u32x2 w; w.x = cvt_pk_bf16(silu_f(cg[0]) * cu[0], silu_f(cg[1]) * cu[1]); w.y = cvt_pk_bf16(silu_f(cg[2]) * cu[2], silu_f(cg[3]) * cu[3]);
        *(u32x2*)(ACT + (size_t)tok * 2816 + ch) = w;
    }
}

template <int DQK, int QT, int KEYS, int NMAP>
__device__ __forceinline__ void attn_unit(LAS unsigned char* lds, const bf16_t* Qp, int qstride, const bf16_t* Kp, int kstride, const bf16_t* VTp, int L, bf16_t* Op, int ostride, int nq, float lam, const float* hnp, float hsc) {
    constexpr int KIMG = KEYS * DQK * 2, KBYTES = NMAP * KIMG, QM = QT / NMAP, VBYTES = 128 * KEYS * 2, STAGE = KBYTES + VBYTES, VG = KEYS / 32;
    constexpr int KPC = DQK / 8, NKP = 64 * KPC / 512, NKS = DQK / 32;
    const int tid = tidx(), wid = tid >> 6, lane = tid & 63, g = lane >> 4, c = lane & 15;
    const int q0 = wid * 16 * QM;
    const int fbase = c * 64 + ((g << 4) ^ ((c >> 3) << 5));
    const bool active = __builtin_amdgcn_readfirstlane(q0) < nq;
    bf16x8 qf[QT][NKS];
#pragma unroll
    for (int qt = 0; qt < QT; ++qt)
#pragma unroll
        for (int ks = 0; ks < NKS; ++ks) qf[qt][ks] = active ? *(const bf16x8*)(Qp + (qt / QM) * 512 + (size_t)(q0 + (qt % QM) * 16 + c) * qstride + ks * 32 + g * 8) : (bf16x8){0, 0, 0, 0, 0, 0, 0, 0};
    f32x4 o[QT][8];
#pragma unroll
    for (int qt = 0; qt < QT; ++qt)
#pragma unroll
        for (int et = 0; et < 8; ++et) o[qt][et] = (f32x4){0.f, 0.f, 0.f, 0.f};
    float lsum[QT];
#pragma unroll
    for (int qt = 0; qt < QT; ++qt) lsum[qt] = 0.f;
    const int nt = L / KEYS;
    constexpr int NKD = (KEYS / 16) * NKS / 8, NVD = 8 * VG / 8;
    const int wv = __builtin_amdgcn_readfirstlane(wid);
    const int drr = lane >> 2, dlp = (lane & 3) ^ ((drr >> 3) << 1);
    unsigned kdo[NKD], vdo[NVD];
#pragma unroll
    for (int i_ = 0; i_ < NKD; ++i_) { const int st_ = wv + 8 * i_, rg_ = st_ / NKS, cs_ = st_ % NKS; kdo[i_] = (unsigned)((rg_ * 16 + drr) * kstride + (cs_ * 4 + dlp) * 8) * 2u; }
#pragma unroll
    for (int i_ = 0; i_ < NVD; ++i_) { const int st_ = wv + 8 * i_, eg_ = st_ / VG, k2_ = st_ % VG; vdo[i_] = (unsigned)((eg_ * 16 + drr) * L + (k2_ * 4 + dlp) * 8) * 2u; }
#define ATT_DMA(t, stg) do { const char* kt_ = (const char*)(Kp + (size_t)(t) * KEYS * kstride); const char* vt_ = (const char*)(VTp + (t) * KEYS); \
        _Pragma("unroll") for (int m_ = 0; m_ < NMAP; ++m_) _Pragma("unroll") for (int i_ = 0; i_ < NKD; ++i_) __builtin_amdgcn_global_load_lds((const unsigned*)(kt_ + m_ * 1024 + kdo[i_]), (LAS unsigned*)(lds + (stg) * STAGE + m_ * KIMG + (wv + 8 * i_) * 1024), 16, 0, 0); \
        _Pragma("unroll") for (int i_ = 0; i_ < NVD; ++i_) __builtin_amdgcn_global_load_lds((const unsigned*)(vt_ + vdo[i_]), (LAS unsigned*)(lds + (stg) * STAGE + KBYTES + (wv + 8 * i_) * 1024), 16, 0, 0); } while (0)
    __syncthreads();
    ATT_DMA(0, 0);
    asm volatile("s_waitcnt vmcnt(0)" ::: "memory");
    __syncthreads();
    for (int t = 0; t < nt; ++t) {
        if (t + 1 < nt) ATT_DMA(t + 1, (t + 1) & 1);
        LAS unsigned char* kb = lds + (t & 1) * STAGE; LAS unsigned char* vb = kb + KBYTES;
        if (active) {
#pragma unroll 1
            for (int k2 = 0; k2 < VG; ++k2) {
                LAS unsigned char* kg = kb + k2 * (2 * NKS * 1024); LAS unsigned char* vg = vb + k2 * 1024;
                f32x4 s[QT][2];
#pragma unroll
                for (int qt = 0; qt < QT; ++qt) { s[qt][0] = (f32x4){0.f, 0.f, 0.f, 0.f}; s[qt][1] = (f32x4){0.f, 0.f, 0.f, 0.f}; }
#pragma unroll
                for (int kk = 0; kk < 2; ++kk)
#pragma unroll
                    for (int ks = 0; ks < NKS; ++ks) {
#pragma unroll
                        for (int m = 0; m < NMAP; ++m) { const bf16x8 kf = *(const LAS bf16x8*)(kg + m * KIMG + fbase + (kk * NKS + ks) * 1024);
#pragma unroll
                            for (int qi = 0; qi < QM; ++qi) s[m * QM + qi][kk] = __builtin_amdgcn_mfma_f32_16x16x32_bf16(kf, qf[m * QM + qi][ks], s[m * QM + qi][kk], 0, 0, 0); } }
                bf16x8 pb[QT];
#pragma unroll
                for (int qt = 0; qt < QT; ++qt) {
#pragma unroll
                    for (int i = 0; i < 4; ++i) { s[qt][0][i] = __builtin_amdgcn_exp2f(s[qt][0][i]); s[qt][1][i] = __builtin_amdgcn_exp2f(s[qt][1][i]); }
                    const f32x4 ps4 = s[qt][0] + s[qt][1]; lsum[qt] += (ps4[0] + ps4[1]) + (ps4[2] + ps4[3]);
                    u32x4 w; w.x = cvt_pk_bf16(s[qt][0][0], s[qt][0][1]); w.y = cvt_pk_bf16(s[qt][0][2], s[qt][0][3]); w.z = cvt_pk_bf16(s[qt][1][0], s[qt][1][1]); w.w = cvt_pk_bf16(s[qt][1][2], s[qt][1][3]);
                    pb[qt] = __builtin_bit_cast(bf16x8, w); }
#pragma unroll
                for (int et = 0; et < 8; ++et) { const bf16x8 vf = *(const LAS bf16x8*)(vg + fbase + (et * VG) * 1024);
#pragma unroll
                    for (int qt = 0; qt < QT; ++qt) o[qt][et] = __builtin_amdgcn_mfma_f32_16x16x32_bf16(vf, pb[qt], o[qt][et], 0, 0, 0); }
            }
        }
        asm volatile("s_waitcnt vmcnt(0)" ::: "memory");
        __syncthreads();
    }
#undef ATT_DMA
    if (active) {
        if constexpr (NMAP == 1) {
#pragma unroll
            for (int qt = 0; qt < QT; ++qt) {
                float l = lsum[qt]; l += __shfl_xor(l, 16); l += __shfl_xor(l, 32); const float inv = 1.0f / l;
                bf16_t* orow = Op + (size_t)(q0 + qt * 16 + c) * ostride + 4 * g;
#pragma unroll
                for (int et = 0; et < 8; ++et) { const f32x4 v = o[qt][et] * inv; u32x2 w; w.x = cvt_pk_bf16(v[0], v[1]); w.y = cvt_pk_bf16(v[2], v[3]); *(u32x2*)(orow + et * 16) = w; }
            }
        } else {
#pragma unroll
            for (int qi = 0; qi < QM; ++qi) {
                float l0 = lsum[qi], l1 = lsum[QM + qi];
                l0 += __shfl_xor(l0, 16); l0 += __shfl_xor(l0, 32); l1 += __shfl_xor(l1, 16); l1 += __shfl_xor(l1, 32);
                const float i0 = 1.0f / l0, i1 = lam / l1; float ss = 0.f;
#pragma unroll
                for (int et = 0; et < 8; ++et) { const f32x4 v = o[qi][et] * i0 - o[QM + qi][et] * i1; o[qi][et] = v; ss += (v[0] * v[0] + v[1] * v[1]) + (v[2] * v[2] + v[3] * v[3]); }
                ss += __shfl_xor(ss, 16); ss += __shfl_xor(ss, 32);
                const float rs = rsqrtf(ss * (1.0f / 128.0f) + EPS) * hsc;
                bf16_t* orow = Op + (size_t)(q0 + qi * 16 + c) * ostride + 4 * g;
#pragma unroll
                for (int et = 0; et < 8; ++et) { const f32x4 v = o[qi][et] * rs * *(const f32x4*)(hnp + et * 16 + 4 * g); u32x2 w; w.x = cvt_pk_bf16(v[0], v[1]); w.y = cvt_pk_bf16(v[2], v[3]); *(u32x2*)(orow + et * 16) = w; }
            }
        }
    }
}

template <int DQK, int QT, int KEYS, int NMAP>
__device__ void phase_attn(LAS unsigned char* lds, const bf16_t* Qh, const bf16_t* Kh, const bf16_t* VT, bf16_t* O, int nh, int stride, int ostride, float lam, const float* hnp, float hsc) {
    constexpr int QB = 128 * QT / NMAP, NQB = 2048 / QB;
    const int nlat = 8 * nh * NQB, ntot = nlat + 16 * nh;
    for (int u = bidx(); u < ntot; u += gridDim.x) {
        int h, tok0, kv0, L, nq; size_t vtb;
        if (u < nlat) { const int qb = u % NQB; h = (u / NQB) % nh; const int b = (u / NQB) / nh; tok0 = TP + b * 2048 + qb * QB; kv0 = TP + b * LLAT; L = LLAT; nq = QB;
            vtb = (size_t)TP * 1024 + (size_t)b * (1024 * LLAT) + (size_t)(h & 7) * 128 * LLAT; }
        else { const int v = u - nlat; h = v % nh; const int b = v / nh; tok0 = b * 256; kv0 = tok0; L = 256; nq = 256; vtb = (size_t)b * (1024 * 256) + (size_t)(h & 7) * 128 * 256; }
        attn_unit<DQK, QT, KEYS, NMAP>(lds, Qh + (size_t)tok0 * stride + h * DQK, stride, Kh + (size_t)kv0 * stride + h * DQK, stride, VT + vtb, L, O + (size_t)tok0 * ostride + h * 128, ostride, nq, lam, hnp, hsc);
    }
}


#define XB_TMO      128
#define XB_XCNT(j)  (256  + 64 * (j))
#define XB_XSUB(j)  (1280 + 64 * (j))
#define XB_XGEN(j)  (2304 + 64 * (j))
#define XB_TOP      3328
#define XB_TOPGEN   3392
#define XCD_BAR_WORDS 3456
#define XB_SPIN_CAP (1u << 22)
__device__ __forceinline__ unsigned xb_ld(unsigned* p)              { return __hip_atomic_load(p, __ATOMIC_RELAXED, __HIP_MEMORY_SCOPE_AGENT); }
__device__ __forceinline__ unsigned xb_add(unsigned* p, unsigned v) { return __hip_atomic_fetch_add(p, v, __ATOMIC_RELAXED, __HIP_MEMORY_SCOPE_AGENT); }
__device__ __forceinline__ unsigned xb_xcc_id() { return (unsigned)__builtin_amdgcn_s_getreg((3 << 11) | 20) & 0xFu; }
#define XB_SPIN(cond, bar) do { unsigned _sp = 0; while (cond) { __builtin_amdgcn_s_sleep(1); \
    if ((++_sp & 255u) == 0u) { if (xb_ld(&(bar)[XB_TMO])) break; if (_sp > XB_SPIN_CAP) { atomicAdd(&(bar)[XB_TMO], 1u); break; } } } } while (0)
struct XcdBarrier { unsigned* bar; unsigned x; volatile LAS unsigned* st; };
__device__ __forceinline__ XcdBarrier xcd_barrier_post(unsigned* bar, volatile LAS unsigned* st) {
    XcdBarrier b; b.bar = bar; b.x = xb_xcc_id(); b.st = st;
    if (threadIdx.x == 0) (void)xb_add(&bar[XB_XCNT(b.x)], 1u);
    return b;
}
__device__ __forceinline__ void xcd_barrier_complete(unsigned* bar, unsigned x, unsigned& nloc, unsigned& nx) {
    const unsigned G = gridDim.x * gridDim.y * gridDim.z;
    unsigned sum, cnt, mine, sp = 0u;
    for (;;) {
        sum = 0u; cnt = 0u; mine = 0u;
#pragma unroll
        for (unsigned j = 0; j < 16; ++j) { const unsigned c = xb_ld(&bar[XB_XCNT(j)]); sum += c; cnt += (c > 0u) ? 1u : 0u; mine = (j == x) ? c : mine; }
        if (sum == G) break;
        __builtin_amdgcn_s_sleep(1);
        if ((++sp & 255u) == 0u) { if (xb_ld(&bar[XB_TMO])) break; if (sp > XB_SPIN_CAP) { atomicAdd(&bar[XB_TMO], 1u); break; } }
    }
    nloc = mine > 0u ? mine : 1u; nx = cnt > 0u ? cnt : 1u;
}
__device__ __forceinline__ void xcd_barrier(const XcdBarrier& b) {
    asm volatile("s_waitcnt vmcnt(0)" ::: "memory");
    __syncthreads();
    if (threadIdx.x == 0) {
        unsigned* bar = b.bar;
        __builtin_amdgcn_s_waitcnt(0);
        unsigned nloc = b.st[0], nx = b.st[1];
        if (nloc == 0u) { xcd_barrier_complete(bar, b.x, nloc, nx); b.st[0] = nloc; b.st[1] = nx; }
        const unsigned old = xb_add(&bar[XB_XSUB(b.x)], 1u);
        const unsigned gen = old / nloc;
        if (old + 1u == (gen + 1u) * nloc) {
            __builtin_amdgcn_fence(__ATOMIC_RELEASE, "agent");
            asm volatile("s_waitcnt vmcnt(0)" ::: "memory");
            const unsigned og = xb_add(&bar[XB_TOP], 1u);
            const unsigned tg = og / nx;
            if (og + 1u == (tg + 1u) * nx) xb_add(&bar[XB_TOPGEN], 1u);
            else XB_SPIN(xb_ld(&bar[XB_TOPGEN]) == tg, bar);
            __builtin_amdgcn_fence(__ATOMIC_ACQUIRE, "agent");
            xb_add(&bar[XB_XGEN(b.x)], 1u);
            asm volatile("s_waitcnt vmcnt(0)" ::: "memory");
        } else {
            XB_SPIN(xb_ld(&bar[XB_XGEN(b.x)]) == gen, bar);
            __builtin_amdgcn_fence(__ATOMIC_ACQUIRE, "agent");
            asm volatile("s_waitcnt vmcnt(0)" ::: "memory");
        }
    }
    __syncthreads();
}

enum { K_P0 = 0, K_NORM1 = 1, K_GDOWN = 2, K_POSTDOWN = 3, K_GUQKV = 4, K_MLAPREP = 5, K_ATT192 = 6, K_GO = 7, K_GO2 = 8,
       K_NORM1D = 9, K_GQKV = 10, K_DPREP = 11, K_ATT64 = 12, K_DCOMB = 13, K_GSIN = 15, K_SCONV = 16, K_GGIN = 19, K_GMLP = 20,
       K_NORM2 = 22, K_GFFN = 23, K_GFFNOUT = 24, K_GFFNOUT2 = 25 };
constexpr int NPHASES = 42;
__device__ __forceinline__ void decode_phase(int ph, int& kind, int& layer) {
    if (ph == 0) { kind = K_P0; layer = 0; return; }
    int i;
    if (ph < 13) { layer = 0; i = ph - 1; if (i < 8) { kind = 1 + i; return; } i -= 8; }
    else if (ph < 24) { layer = 1; i = ph - 13; if (i < 7) { kind = i < 5 ? 9 + i : (i == 5 ? K_GO : K_GO2); return; } i -= 7; }
    else if (ph < 33) { layer = 2; i = ph - 24; if (i < 5) { kind = i == 0 ? K_NORM1 : (i == 1 ? K_GSIN : (i == 2 ? K_SCONV : (i == 3 ? K_GO : K_GO2))); return; } i -= 5; }
    else { layer = 3; i = ph - 33; if (i < 5) { kind = i == 0 ? K_NORM1 : (i == 1 ? K_GGIN : (i == 2 ? K_GMLP : (i == 3 ? K_GO : K_GO2))); return; } i -= 5; }
    kind = K_NORM2 + i;
}
#ifndef ENMASK
#define ENMASK 0xffffffffffffffffull
#endif
#define EN(k) ((ENMASK >> (k)) & 1ull)
#ifndef DUP_MASK
#define DUP_MASK 0ull
#endif
#ifndef ATT64_QT
#define ATT64_QT 4
#endif
#ifndef EXTRA_SYNCS
#define EXTRA_SYNCS 0
#endif

__global__ void __launch_bounds__(NTHREADS) mega(Params p_, int lo, int hi) {
    extern __shared__ __attribute__((aligned(16))) unsigned char smem[];
    LAS unsigned char* lds = (LAS unsigned char*)smem;
    cg::grid_group grid = cg::this_grid();
    const int G = gridDim.x, bid = bidx();
    volatile LAS unsigned* xst = (volatile LAS unsigned*)(lds + 131072);
    if (threadIdx.x < 4) xst[threadIdx.x] = 0u;
    __syncthreads();
    const XcdBarrier xbar = xcd_barrier_post((unsigned*)(p_.ws + WS_BAR), xst);
    if (hi < 0) grid.sync();
#define SEAM(first_) do { xcd_barrier(xbar); } while (0)
#define GEMM(EpiT, Aptr, Bptr, M_, N_, K_, ...) do { pg8::Gemm g_{(Aptr), (Bptr), (M_), (N_), (K_)}; pg8::StaticOrder S_; S_.init((M_), (N_), G, bid); EpiT E_{__VA_ARGS__}; pg8::gemm_phase<EpiT, pg8::StaticOrder>(lds, g_, S_, E_); } while (0)
    for (int ph = lo; ph < hi; ++ph) {
        int kind, layer; decode_phase(ph, kind, layer);
        KP p = (KP)__builtin_amdgcn_kernarg_segment_ptr(); asm volatile("" : "+s"(p));
        bf16_t* W = (bf16_t*)(p->ws + WS_W);
        bf16_t* H = (bf16_t*)(p->ws + WS_H);
        unsigned char* AR = p->ws + WS_AR;
        const float* MOD = (const float*)(p->ws + WS_MOD);
        const bool dup = (DUP_MASK >> ph) & 1ull; const bool fast = (G == 256);
        if (kind == K_DCOMB) continue;
        for (int rep = 0; rep < (dup ? 2 : 1); ++rep) {
        float* Yo = (dup && rep == 0) ? (float*)(AR + F_HALO + 14417920) : p->out;
        switch (kind) {
        case K_P0: if (EN(0)) phase0(p, lds); break;
        case K_NORM1: if (EN(1)) phase_norm(p, layer, 0, layer == 0, (fast && layer > 0) ? 16384 : 0, T, G, bid); break;
        case K_NORM1D: if (EN(1)) { phase_norm(p, layer, 0, 0, fast ? 16384 : 0, T, G, bid); phase_diff_cache(p); } break;
        case K_NORM2: if (EN(1)) phase_norm(p, layer, 1, 0, fast ? 16384 : 0, T, G, bid); break;
        case K_GDOWN: if (EN(2)) GEMM(EpiF32Plain, H, W + OW_DOWN, T, 1280, 1024, (float*)(AR + A_DN), 1280); break;
        case K_POSTDOWN: if (EN(3)) phase_mla_post_down(p); break;
        case K_GUQKV: case K_GSIN: {
            const bool uq = kind == K_GUQKV;
            if (EN(4)) GEMM(EpiBf16<0>, uq ? (const bf16_t*)(AR + A_CQ) : (const bf16_t*)H, W + (uq ? OW_UQ : OW_SIN), T, uq ? 1536 : 3072, uq ? 768 : 1024, uq ? (bf16_t*)(AR + A_QH) : (bf16_t*)AR, uq ? 1536 : 3072, (float*)nullptr, 0);
            if (uq && EN(5)) GEMM(EpiKV, (const bf16_t*)(AR + A_KVIN), W + OW_UKV, KVT, 2048, 256, (bf16_t*)(AR + A_KH), H);
        } break;
        case K_MLAPREP: if (EN(6)) { phase_mla_headprep(p); phase_vtrans(lds, H, (bf16_t*)(AR + A_VT)); } break;
        case K_ATT192: if (EN(7)) phase_attn<192, 2, 64, 1>(lds, (const bf16_t*)(AR + A_QH), (const bf16_t*)(AR + A_KH), (const bf16_t*)(AR + A_VT), H, 8, 1536, 1024, 0.f, (const float*)nullptr, 0.f); break;
        case K_GO: case K_GFFNOUT: case K_GO2: case K_GFFNOUT2: {
            const bool f = (kind == K_GFFNOUT || kind == K_GFFNOUT2), r2 = (kind == K_GO2 || kind == K_GFFNOUT2);
            const size_t woff = f ? OW_FFN + (size_t)layer * FFN_STRIDE + FIN_ELEMS : (layer == 0 ? OW_OMLA : (layer == 1 ? OW_ODIFF : (layer == 2 ? OW_SOUT : OW_GOUT)));
            const bf16_t* Ap = f ? (const bf16_t*)(AR + F_ACT) : (const bf16_t*)H; const int Kd = f ? 2816 : 1024;
            const float* gatep = MOD + (size_t)(layer * 9) * 6144 + (f ? 5120 : 2048); const int frst = (!f && layer == 0) ? 1 : 0;
            if (fast) {
                pg8::PanelOrder S_; S_.c = bid; S_.round = r2 ? 1 : 0; Unit u0;
                if (S_.next(0, u0)) {
                    if (f) { ffn_fix_panel(p, layer, u0.pm); asm volatile("s_waitcnt vmcnt(0)" ::: "memory"); __syncthreads(); }
                    pg8::Gemm g_{Ap, W + woff, T, 1024, Kd}; EpiResid E_{p->in[0], p->in[1], p->out, p->out, gatep, frst};
                    if (EN(8)) pg8::gemm_phase<EpiResid, pg8::PanelOrder>(lds, g_, S_, E_);
                } else if (r2) {
                    if (!(f && layer == 3)) phase_norm(p, f ? layer + 1 : layer, f ? 0 : 1, 0, 0, 16384, G - 64, bid - 64);
                    if (layer < 3 && f) { conv_next(p, lds, layer + 1, 0, G - 64, bid - 64); conv_next(p, lds, layer + 1, 1, G - 64, bid - 64); }
                }
            } else if (!r2) {
                if (f) { pg8::StaticOrder S0; S0.init(T, 1024, G, bid); Unit u0;
                    for (int i = 0; S0.next(i, u0); ++i) ffn_fix_panel(p, layer, u0.pm);
                    asm volatile("s_waitcnt vmcnt(0)" ::: "memory"); __syncthreads(); }
                if (EN(8)) GEMM(EpiResid, Ap, W + woff, T, 1024, Kd, p->in[0], p->in[1], p->out, p->out, gatep, frst);
                if (layer < 3) conv_next(p, lds, layer + 1, f ? 1 : 0, G, bid);
            }
        } break;
        case K_GQKV: if (EN(9)) GEMM(EpiQKV, H, W + OW_QKV, T, 3072, 1024, (bf16_t*)(AR + D_QH), (bf16_t*)(AR + D_KH), (bf16_t*)(AR + D_O2), p->out + O_DV); break;
        case K_DPREP: if (EN(10)) { phase_diff_headprep(p); phase_vtrans(lds, (const bf16_t*)(AR + D_O2), (bf16_t*)(AR + D_VT)); } break;
        case K_ATT64: if (EN(11)) {
            const int ln = tidx() & 63; const float lam_init = 0.8f - 0.6f * expf(-0.3f);
            const float d1 = wave_sum(p->in[26][ln] * p->in[27][ln]), d2 = wave_sum(p->in[28][ln] * p->in[29][ln]);
            phase_attn<64, 4, 128, 2>(lds, (const bf16_t*)(AR + D_QH), (const bf16_t*)(AR + D_KH), (const bf16_t*)(AR + D_VT), H, 8, 1024, 1024, expf(d1) - expf(d2) + lam_init, p->in[30], 1.0f - lam_init); } break;
        case K_DCOMB: break;
        case K_SCONV: if (EN(13)) phase_sconv_ew(p); break;
        case K_GGIN: if (EN(14)) GEMM(EpiBf16<1>, H, W + OW_GIN, T, 2048, 1024, (bf16_t*)AR, 2048, (float*)(p->ws + WS_GST), 4); break;
        case K_GMLP: if (EN(15)) phase_gmlp_spatial(p, lds); break;
        case K_GFFN: if (EN(16)) GEMM(EpiFFN, H, W + OW_FFN + (size_t)layer * FFN_STRIDE, T, 5632, 1024, (bf16_t*)(AR + F_ACT), (float*)(AR + F_HALO), p->in[41] + (size_t)layer * 3 * 5632, p->in[42] + (size_t)layer * 5632); break;
        default: break;
        }
        if (dup && rep == 0) SEAM(0);
        }
        if (ph == 0) for (int e = 0; e < EXTRA_SYNCS; ++e) SEAM(0);
        if (ph + 1 < hi) SEAM(ph == lo);
    }
}

extern "C" void kernel_launch(void* const* d_in, const int* in_sizes, int n_in, void* d_out, int out_size, void* d_ws, size_t ws_size, hipStream_t stream) {
    static int grid_blocks = 0;
    if (!grid_blocks) {
        if (n_in != 44 || ws_size < WS_END) { fprintf(stderr, "kernel_launch: unexpected n_in %d / ws_size %zu (need %zu)\n", n_in, ws_size, (size_t)WS_END); }
        int dev = 0, cus = 0, per_cu = 0;
        hipGetDevice(&dev);
        hipDeviceGetAttribute(&cus, hipDeviceAttributeMultiprocessorCount, dev);
        hipFuncSetAttribute((const void*)mega, hipFuncAttributeMaxDynamicSharedMemorySize, LDS_BYTES);
        hipOccupancyMaxActiveBlocksPerMultiprocessor(&per_cu, (const void*)mega, NTHREADS, LDS_BYTES);
        if (per_cu < 1) per_cu = 1;
        grid_blocks = cus * per_cu;
        (void)hipGetLastError();
    }
    Params p{};
    for (int i = 0; i < 44; ++i) p.in[i] = (const float*)d_in[i];
    p.out = (float*)d_out; p.ws = (unsigned char*)d_ws;
    (void)hipMemsetAsync((unsigned char*)d_ws + WS_BAR, 0, XCD_BAR_WORDS * 4, stream);
    int lo = 0, hi = NPHASES;
    void* args[] = {&p, &lo, &hi};
    hipError_t e = hipLaunchCooperativeKernel((const void*)mega, dim3(grid_blocks), dim3(NTHREADS), args, LDS_BYTES, stream);
    if (e != hipSuccess) fprintf(stderr, "cooperative launch failed: %s (grid %d)\n", hipGetErrorString(e), grid_blocks);
}
```
